# Optimizing an MI355X kernel written in HIP

```python
import math
import jax
import jax.numpy as jnp
from jax import lax
import numpy as np

D_MODEL = 1024
BATCH = 8
SEQ = 4096
DEPTH = 4

HEAD_DIM = 64
N_MIX_HEADS = D_MODEL // HEAD_DIM
N_GROUPS = 4
HEADS_PER_GROUP = N_MIX_HEADS // N_GROUPS
GROUP_WIDTH = HEADS_PER_GROUP * HEAD_DIM
Q_BLOCK = 128
NEG = -1e30

REL_BUCKETS = 32
REL_MAX_DIST = 128

IDX_HEADS = 8
IDX_DIM = 64
DSA_TOPK = 256

CMP_LEN = 32
CMP_STRIDE = 16
SLC_LEN = 64
SLC_TOPN = 16
WIN = 512

MOBA_BLOCK = 256
MOBA_TOPK = 3
MOBA_Q_BLOCK = 32

DIFF_HALF = HEAD_DIM // 2

MEM_LEN = 256
CROSS_HEADS = 4
CROSS_DIM = D_MODEL // CROSS_HEADS
D_FF = 4 * D_MODEL

DEEPNORM_ALPHA = (2 * DEPTH) ** 0.25
DEEPNORM_BETA = (8 * DEPTH) ** -0.25

G = GROUP_WIDTH
SPLIT_SIZES = (
    G, G, G, IDX_HEADS * IDX_DIM, IDX_DIM, IDX_HEADS,
    G, HEAD_DIM, HEAD_DIM, HEAD_DIM, HEAD_DIM, HEAD_DIM, HEAD_DIM,
    3 * HEADS_PER_GROUP,
    G, G, G,
    G, G, G,
)
IN_COLS = sum(SPLIT_SIZES)

kernel_name = 'hybrid_dsa_nsa_moba_diff_trunk'


def split_cols(h):
    offs = np.cumsum(SPLIT_SIZES)[:-1].tolist()
    return jnp.split(h, offs, axis=-1)


def heads(t, n):
    return t.reshape(t.shape[0], t.shape[1], n, -1)


def gather_rows(src, idx):
    return jax.vmap(lambda s, i: s[i])(src, idx)


def layer_norm(x, g, b, eps=1e-5):
    xf = x.astype(jnp.float32)
    mu = xf.mean(-1, keepdims=True)
    var = jnp.square(xf - mu).mean(-1, keepdims=True)
    return ((xf - mu) * lax.rsqrt(var + eps) * g + b).astype(x.dtype)


def rms_norm(x, g, eps=1e-6):
    xf = x.astype(jnp.float32)
    return (xf * lax.rsqrt(jnp.mean(xf * xf, -1, keepdims=True) + eps) * g).astype(x.dtype)


def masked_softmax(logits, mask):
    logits = jnp.where(mask, logits.astype(jnp.float32), NEG)
    return jax.nn.softmax(logits, axis=-1) * mask


def rel_bucket(dist):
    n = jnp.maximum(dist, 0)
    max_exact = REL_BUCKETS // 2
    nf = jnp.maximum(n, max_exact).astype(jnp.float32)
    large = max_exact + (jnp.log(nf / max_exact) / math.log(REL_MAX_DIST / max_exact)
                         * (REL_BUCKETS - max_exact)).astype(jnp.int32)
    large = jnp.minimum(large, REL_BUCKETS - 1)
    return jnp.where(n < max_exact, n, large)


def sweep(fn, L, blk):
    starts = jnp.arange(L // blk, dtype=jnp.int32) * blk
    out = lax.map(fn, starts)
    nb, B, _, H, d = out.shape
    return out.transpose(1, 0, 2, 3, 4).reshape(B, L, H * d)


def dsa_attention(q, k, v, q_idx, k_idx, w_idx, rel_tab):
    B, L, H, Dh = q.shape
    topk = min(DSA_TOPK, L // 4)
    key_pos = jnp.arange(L, dtype=jnp.int32)

    def block(q0):
        qb = lax.dynamic_slice_in_dim(q, q0, Q_BLOCK, axis=1)
        qib = lax.dynamic_slice_in_dim(q_idx, q0, Q_BLOCK, axis=1)
        wib = lax.dynamic_slice_in_dim(w_idx, q0, Q_BLOCK, axis=1)
        qpos = q0 + jnp.arange(Q_BLOCK, dtype=jnp.int32)
        rel = jax.nn.relu(jnp.einsum('bqhd,bsd->bhqs', qib, k_idx) * IDX_DIM ** -0.5)
        score = jnp.einsum('bqh,bhqs->bqs', wib, rel).astype(jnp.float32) * IDX_HEADS ** -0.5
        score = jnp.where(key_pos[None, None, :] <= qpos[None, :, None], score, -jnp.inf)
        _, sel = lax.top_k(score, topk)
        kg = gather_rows(k, sel)
        vg = gather_rows(v, sel)
        dist = qpos[None, :, None] - sel
        bias = rel_tab[rel_bucket(dist)].transpose(0, 3, 1, 2)
        logits = jnp.einsum('bqhd,bqkhd->bhqk', qb, kg) * Dh ** -0.5 + bias
        p = masked_softmax(logits, (dist >= 0)[:, None])
        return jnp.einsum('bhqk,bqkhd->bqhd', p.astype(v.dtype), vg)

    return sweep(block, L, Q_BLOCK)


def nsa_attention(q, k_cmp_raw, v_cmp_raw, k_slc, v_slc, k_win, v_win, gate_logits,
                  pos_k, pos_v, w1_k, w2_k, w1_v, w2_v, rel_tab):
    B, L, H, Dh = q.shape
    n_cmp = (L - CMP_LEN) // CMP_STRIDE + 1
    cmp_start = np.arange(n_cmp) * CMP_STRIDE
    cmp_idx = cmp_start[:, None] + np.arange(CMP_LEN)[None, :]
    cmp_end = jnp.asarray(cmp_start + CMP_LEN - 1, jnp.int32)

    def compress(t, pos, w1, w2):
        blocks = (t[:, cmp_idx] + pos).reshape(B, n_cmp, CMP_LEN * Dh)
        return jax.nn.gelu(blocks @ w1) @ w2

    kc = compress(k_cmp_raw, pos_k, w1_k, w2_k)
    vc = compress(v_cmp_raw, pos_v, w1_v, w2_v)
    n_slc = L // SLC_LEN
    topn = min(SLC_TOPN, n_slc)
    slc_start = np.arange(n_slc) * SLC_LEN
    overlap = jnp.asarray(((cmp_start[:, None] <= slc_start[None, :] + SLC_LEN - 1)
                           & (cmp_start[:, None] + CMP_LEN - 1 >= slc_start[None, :])).astype(np.float32))
    slc_start_j = jnp.asarray(slc_start, jnp.int32)
    slc_ids = jnp.arange(n_slc, dtype=jnp.int32)
    slc_offs = jnp.arange(SLC_LEN, dtype=jnp.int32)
    k_win_pad = jnp.pad(k_win, ((0, 0), (WIN, 0), (0, 0)))
    v_win_pad = jnp.pad(v_win, ((0, 0), (WIN, 0), (0, 0)))
    win_offs = jnp.arange(WIN + Q_BLOCK, dtype=jnp.int32) - WIN
    gates = jax.nn.sigmoid(gate_logits.astype(jnp.float32)).astype(q.dtype).reshape(B, L, H, 3)
    scale = Dh ** -0.5

    def block(q0):
        qb = lax.dynamic_slice_in_dim(q, q0, Q_BLOCK, axis=1)
        gb = lax.dynamic_slice_in_dim(gates, q0, Q_BLOCK, axis=1)
        qpos = q0 + jnp.arange(Q_BLOCK, dtype=jnp.int32)
        lc = jnp.einsum('bqhd,bnd->bhqn', qb, kc) * scale
        pc = masked_softmax(lc, cmp_end[None, :] <= qpos[:, None])
        o_cmp = jnp.einsum('bhqn,bnd->bqhd', pc.astype(vc.dtype), vc)
        imp = jnp.einsum('bhqn,nj->bqj', pc, overlap)
        cur = qpos // SLC_LEN
        forced = ((slc_ids[None, :] == 0) | (slc_ids[None, :] == cur[:, None])
                  | (slc_ids[None, :] == cur[:, None] - 1))
        imp = jnp.where(forced, jnp.inf, imp)
        imp = jnp.where(slc_start_j[None, :] <= qpos[:, None], imp, -jnp.inf)
        _, sel = lax.top_k(imp, topn)
        tok = (sel[..., None] * SLC_LEN + slc_offs).reshape(B, Q_BLOCK, topn * SLC_LEN)
        ksg = gather_rows(k_slc, tok)
        vsg = gather_rows(v_slc, tok)
        dist_s = qpos[None, :, None] - tok
        ls = (jnp.einsum('bqhd,bqnd->bhqn', qb, ksg) * scale
              + rel_tab[rel_bucket(dist_s)].transpose(0, 3, 1, 2))
        ps = masked_softmax(ls, (dist_s >= 0)[:, None])
        o_slc = jnp.einsum('bhqn,bqnd->bqhd', ps.astype(vsg.dtype), vsg)
        kwb = lax.dynamic_slice_in_dim(k_win_pad, q0, WIN + Q_BLOCK, axis=1)
        vwb = lax.dynamic_slice_in_dim(v_win_pad, q0, WIN + Q_BLOCK, axis=1)
        kpos = q0 + win_offs
        dist_w = qpos[:, None] - kpos[None, :]
        mask_w = (dist_w >= 0) & (dist_w < WIN) & (kpos[None, :] >= 0)
        lw = (jnp.einsum('bqhd,bkd->bhqk', qb, kwb) * scale
              + rel_tab[rel_bucket(dist_w)].transpose(2, 0, 1)[None])
        pw = masked_softmax(lw, mask_w)
        o_win = jnp.einsum('bhqk,bkd->bqhd', pw.astype(vwb.dtype), vwb)
        return gb[..., 0:1] * o_cmp + gb[..., 1:2] * o_slc + gb[..., 2:3] * o_win

    return sweep(block, L, Q_BLOCK)


def moba_attention(q, k, v, rel_tab):
    B, L, H, Dh = q.shape
    nb = -(-L // MOBA_BLOCK)
    pad = nb * MOBA_BLOCK - L
    k_pad = jnp.pad(k, ((0, 0), (0, pad), (0, 0), (0, 0)))
    v_pad = jnp.pad(v, ((0, 0), (0, pad), (0, 0), (0, 0)))
    k_blk = k_pad.reshape(B, nb, MOBA_BLOCK, H, Dh)
    k_mean = k_blk.mean(axis=2)
    k_bh = k_blk.transpose(0, 3, 1, 2, 4)
    v_bh = v_pad.reshape(B, nb, MOBA_BLOCK, H, Dh).transpose(0, 3, 1, 2, 4)
    topk = min(MOBA_TOPK, nb - 1)
    offs = jnp.arange(MOBA_BLOCK, dtype=jnp.int32)
    blk_ids = jnp.arange(nb, dtype=jnp.int32)
    h_ids = jnp.arange(H)[None, :, None, None, None]
    tab_t = rel_tab.T
    scale = Dh ** -0.5
    gather2 = jax.vmap(jax.vmap(lambda s, i: s[i]))

    def block(q0):
        qb = lax.dynamic_slice_in_dim(q, q0, MOBA_Q_BLOCK, axis=1)
        qpos = q0 + jnp.arange(MOBA_Q_BLOCK, dtype=jnp.int32)
        cur = q0 // MOBA_BLOCK
        ko = lax.dynamic_slice_in_dim(k_pad, cur * MOBA_BLOCK, MOBA_BLOCK, axis=1)
        vo = lax.dynamic_slice_in_dim(v_pad, cur * MOBA_BLOCK, MOBA_BLOCK, axis=1)
        dist_o = qpos[:, None] - (cur * MOBA_BLOCK + offs)[None, :]
        lo = (jnp.einsum('bqhd,bkhd->bhqk', qb, ko) * scale
              + rel_tab[rel_bucket(dist_o)].transpose(2, 0, 1)[None])
        mask_o = jnp.broadcast_to(dist_o >= 0, lo.shape)
        if topk == 0:
            p = masked_softmax(lo, mask_o).astype(v.dtype)
            return jnp.einsum('bhqk,bkhd->bqhd', p, vo)
        gate = jnp.einsum('bqhd,bnhd->bhqn', qb, k_mean).astype(jnp.float32)
        gate = jnp.where(blk_ids < cur, gate, -jnp.inf)
        gval, sel = lax.top_k(gate, topk)
        kg = gather2(k_bh, sel)
        vg = gather2(v_bh, sel)
        dist_p = qpos[None, None, :, None, None] - (sel[..., None] * MOBA_BLOCK + offs)
        lp = (jnp.einsum('bqhd,bhqjkd->bhqjk', qb, kg) * scale
              + tab_t[h_ids, rel_bucket(dist_p)])
        mask_p = jnp.broadcast_to(jnp.isfinite(gval)[..., None], lp.shape)
        n_p = topk * MOBA_BLOCK
        logits = jnp.concatenate([lo, lp.reshape(B, H, MOBA_Q_BLOCK, n_p)], axis=-1)
        mask = jnp.concatenate([mask_o, mask_p.reshape(B, H, MOBA_Q_BLOCK, n_p)], axis=-1)
        p = masked_softmax(logits, mask).astype(v.dtype)
        po = p[..., :MOBA_BLOCK]
        pp = p[..., MOBA_BLOCK:].reshape(B, H, MOBA_Q_BLOCK, topk, MOBA_BLOCK)
        return (jnp.einsum('bhqk,bkhd->bqhd', po, vo)
                + jnp.einsum('bhqjk,bhqjkd->bqhd', pp, vg))

    return sweep(block, L, MOBA_Q_BLOCK)


def diff_attention(q, k, v, lam, lam_init, norm_g, rel_tab):
    B, L, H, Dh = v.shape
    q2 = q.reshape(B, L, H, 2, DIFF_HALF)
    k2 = k.reshape(B, L, H, 2, DIFF_HALF)
    key_pos = jnp.arange(L, dtype=jnp.int32)

    def block(q0):
        qb = lax.dynamic_slice_in_dim(q2, q0, Q_BLOCK, axis=1)
        qpos = q0 + jnp.arange(Q_BLOCK, dtype=jnp.int32)
        dist = qpos[:, None] - key_pos[None, :]
        bias = rel_tab[rel_bucket(dist)].transpose(2, 0, 1)
        logits = (jnp.einsum('bqhcd,bkhcd->bhcqk', qb, k2) * DIFF_HALF ** -0.5
                  + bias[None, :, None])
        p = masked_softmax(logits, dist >= 0)
        a = p[:, :, 0] - lam * p[:, :, 1]
        return jnp.einsum('bhqk,bkhd->bqhd', a.astype(v.dtype), v)

    o = sweep(block, L, Q_BLOCK).reshape(B, L, H, Dh)
    o = rms_norm(o, norm_g) * (1.0 - lam_init)
    return o.reshape(B, L, H * Dh)


def cross_attention(x, mem, wq, wk, wv, wo):
    B, L, _ = x.shape
    q = (x @ wq).reshape(B, L, CROSS_HEADS, CROSS_DIM)
    k = (mem @ wk).reshape(B, -1, CROSS_HEADS, CROSS_DIM)
    v = (mem @ wv).reshape(B, -1, CROSS_HEADS, CROSS_DIM)
    logits = jnp.einsum('bqhd,bmhd->bhqm', q, k).astype(jnp.float32) * CROSS_DIM ** -0.5
    p = jax.nn.softmax(logits, axis=-1).astype(v.dtype)
    o = jnp.einsum('bhqm,bmhd->bqhd', p, v).reshape(B, L, D_MODEL)
    return o @ wo


def squared_relu_mlp(x, w1, w2):
    return jnp.square(jax.nn.relu(x @ w1)) @ w2


def setup_inputs(seed: int = 0) -> dict:
    key = jax.random.key(seed)
    ks = jax.random.split(key, 32)

    def nrm(k, shape, scale):
        return jax.random.normal(k, shape, jnp.float32) * scale

    D = D_MODEL
    return {
        'x': nrm(ks[0], (BATCH, SEQ, D), 1.0),
        'mem': nrm(ks[1], (BATCH, MEM_LEN, D), 1.0),
        'rel_bias': nrm(ks[2], (REL_BUCKETS, N_MIX_HEADS), 0.2),
        'w_in': nrm(ks[3], (DEPTH, D, IN_COLS), D ** -0.5),
        'w_out': nrm(ks[4], (DEPTH, D, D), D ** -0.5 * DEEPNORM_BETA),
        'nsa_pos_k': nrm(ks[5], (DEPTH, CMP_LEN, HEAD_DIM), 0.1),
        'nsa_pos_v': nrm(ks[6], (DEPTH, CMP_LEN, HEAD_DIM), 0.1),
        'nsa_w1_k': nrm(ks[7], (DEPTH, CMP_LEN * HEAD_DIM, HEAD_DIM), (CMP_LEN * HEAD_DIM) ** -0.5),
        'nsa_w2_k': nrm(ks[8], (DEPTH, HEAD_DIM, HEAD_DIM), HEAD_DIM ** -0.5),
        'nsa_w1_v': nrm(ks[9], (DEPTH, CMP_LEN * HEAD_DIM, HEAD_DIM), (CMP_LEN * HEAD_DIM) ** -0.5),
        'nsa_w2_v': nrm(ks[10], (DEPTH, HEAD_DIM, HEAD_DIM), HEAD_DIM ** -0.5),
        'diff_lq1': nrm(ks[11], (DEPTH, DIFF_HALF), 0.1),
        'diff_lk1': nrm(ks[12], (DEPTH, DIFF_HALF), 0.1),
        'diff_lq2': nrm(ks[13], (DEPTH, DIFF_HALF), 0.1),
        'diff_lk2': nrm(ks[14], (DEPTH, DIFF_HALF), 0.1),
        'diff_g': 1.0 + nrm(ks[15], (DEPTH, HEAD_DIM), 0.01),
        'ln1_g': 1.0 + nrm(ks[16], (DEPTH, D), 0.01),
        'ln1_b': nrm(ks[17], (DEPTH, D), 0.01),
        'xq': nrm(ks[18], (DEPTH, D, D), D ** -0.5),
        'xk': nrm(ks[19], (DEPTH, D, D), D ** -0.5),
        'xv': nrm(ks[20], (DEPTH, D, D), D ** -0.5),
        'xo': nrm(ks[21], (DEPTH, D, D), D ** -0.5 * DEEPNORM_BETA),
        'ln2_g': 1.0 + nrm(ks[22], (DEPTH, D), 0.01),
        'ln2_b': nrm(ks[23], (DEPTH, D), 0.01),
        'mlp_w1': nrm(ks[24], (DEPTH, D, D_FF), D ** -0.5),
        'mlp_w2': nrm(ks[25], (DEPTH, D_FF, D), D_FF ** -0.5 * DEEPNORM_BETA),
        'ln3_g': 1.0 + nrm(ks[26], (DEPTH, D), 0.01),
        'ln3_b': nrm(ks[27], (DEPTH, D), 0.01),
    }


def reference(x, mem, rel_bias, w_in, w_out, nsa_pos_k, nsa_pos_v, nsa_w1_k, nsa_w2_k,
              nsa_w1_v, nsa_w2_v, diff_lq1, diff_lk1, diff_lq2, diff_lk2, diff_g,
              ln1_g, ln1_b, xq, xk, xv, xo, ln2_g, ln2_b, mlp_w1, mlp_w2, ln3_g, ln3_b):
    HG = HEADS_PER_GROUP
    tabs = [rel_bias[:, g * HG:(g + 1) * HG] for g in range(N_GROUPS)]
    for l in range(DEPTH):
        h = x @ w_in[l]
        (a_q, a_k, a_v, a_qi, a_ki, a_w,
         b_q, b_kc, b_vc, b_ks, b_vs, b_kw, b_vw, b_g,
         c_q, c_k, c_v, d_q, d_k, d_v) = split_cols(h)
        o_a = dsa_attention(heads(a_q, HG), heads(a_k, HG), heads(a_v, HG),
                            heads(a_qi, IDX_HEADS), a_ki, a_w, tabs[0])
        o_b = nsa_attention(heads(b_q, HG), b_kc, b_vc, b_ks, b_vs, b_kw, b_vw, b_g,
                            nsa_pos_k[l], nsa_pos_v[l], nsa_w1_k[l], nsa_w2_k[l],
                            nsa_w1_v[l], nsa_w2_v[l], tabs[1])
        o_c = moba_attention(heads(c_q, HG), heads(c_k, HG), heads(c_v, HG), tabs[2])
        lam_init = 0.8 - 0.6 * math.exp(-0.3 * l)
        lam = (jnp.exp(jnp.sum(diff_lq1[l].astype(jnp.float32) * diff_lk1[l]))
               - jnp.exp(jnp.sum(diff_lq2[l].astype(jnp.float32) * diff_lk2[l])) + lam_init)
        o_d = diff_attention(heads(d_q, HG), heads(d_k, HG), heads(d_v, HG), lam, lam_init,
                             diff_g[l], tabs[3])
        mix = jnp.concatenate([o_a, o_b, o_c, o_d], axis=-1).astype(x.dtype) @ w_out[l]
        x = layer_norm(DEEPNORM_ALPHA * x + mix, ln1_g[l], ln1_b[l])
        x = layer_norm(DEEPNORM_ALPHA * x + cross_attention(x, mem, xq[l], xk[l], xv[l], xo[l]),
                       ln2_g[l], ln2_b[l])
        x = layer_norm(DEEPNORM_ALPHA * x + squared_relu_mlp(x, mlp_w1[l], mlp_w2[l]),
                       ln3_g[l], ln3_b[l])
    return x
```

```cpp
#include <hip/hip_runtime.h>
#include <hip/hip_cooperative_groups.h>
#include <cstdio>
namespace cg = cooperative_groups;

typedef unsigned short u16;
typedef unsigned char uchar;
typedef short bf16x8 __attribute__((ext_vector_type(8)));
typedef short s16x4 __attribute__((ext_vector_type(4)));
typedef float f32x16 __attribute__((ext_vector_type(16)));

#define DI __device__ __forceinline__

constexpr int NB = 8, SL = 4096, DM = 1024, DEPTH = 4, NT = NB * SL;
constexpr int HC = 3584;
constexpr int IN_COLS = 3540;
constexpr int DFF = 4096;
constexpr int A_Q = 0, A_K = 256, A_V = 512, A_QI = 768, A_KI = 1280;
constexpr int B_Q = 1344, B_KC = 1600, B_VC = 1664, B_KS = 1728, B_VS = 1792, B_KW = 1856, B_VW = 1920;
constexpr int C_Q = 1984, C_K = 2240, C_V = 2496, D_Q = 2752, D_K = 3008, D_V = 3264, A_W = 3520, B_G = 3528;
constexpr float ALPHA = 1.681792830507429f;
constexpr int LDS_BYTES = 75776;
constexpr int NTHREADS = 256;
#define REP_G 1
#define REP_P2 1
#define REP_P3 1
#define REP_X 1

constexpr size_t W_IN = 0;
constexpr size_t W_OUT = W_IN + (size_t)HC * 1024 * 2;
constexpr size_t W_XQ = W_OUT + 2097152;
constexpr size_t W_XK = W_XQ + 2097152;
constexpr size_t W_XV = W_XK + 2097152;
constexpr size_t W_XO = W_XV + 2097152;
constexpr size_t W_1 = W_XO + 2097152;
constexpr size_t W_2 = W_1 + 8388608;
constexpr size_t W_END = W_2 + 8388608;
constexpr size_t OFF_XB = W_END;
constexpr size_t OFF_H = OFF_XB + (size_t)NT * 1024 * 2;
constexpr size_t OFF_O = OFF_H + (size_t)NT * 4096 * 2;
constexpr size_t OFF_MEMB = OFF_O + (size_t)NT * 1024 * 2;
constexpr size_t OFF_KV = OFF_MEMB + 2048 * 1024 * 2;
constexpr size_t OFF_KC = OFF_KV + 2048 * 2048 * 2;
constexpr size_t OFF_VC = OFF_KC + 8 * 256 * 64 * 2;
constexpr size_t OFF_KM = OFF_VC + 8 * 256 * 64 * 2;
constexpr size_t OFF_SEL = OFF_KM + 8 * 16 * 256 * 4;
constexpr size_t OFF_CTR = OFF_SEL + (size_t)NT * 256 * 2;
constexpr size_t CTR_BYTES = 2048;
constexpr size_t OFF_BAR = OFF_CTR + CTR_BYTES;
constexpr size_t BAR_BYTES = 3456 * 4;
constexpr size_t OFF_STATS = OFF_BAR + BAR_BYTES;
constexpr size_t OFF_KIF = OFF_STATS + (size_t)128 * 8 * 256 * 8;
constexpr size_t WS_END = OFF_KIF + (size_t)NT * 64 * 2;

struct Params {
  const float* in[28];
  float* out;
  uchar* ws;
};

typedef const Params __attribute__((address_space(4))) CParams;
struct KP {
  CParams* p;
  DI const float* in(int i) const { return p->in[i]; }
  DI float* out() const { return p->out; }
  DI uchar* ws() const { return p->ws; }
};
DI KP kparams() {
  KP k;
#if defined(__HIP_DEVICE_COMPILE__)
  k.p = (CParams*)__builtin_amdgcn_kernarg_segment_ptr();
  asm volatile("" : "+s"(k.p));
#else
  k.p = nullptr;
#endif
  return k;
}
__device__ const uchar BUCKET_LUT[132] = {0, 1, 2, 3, 4, 5, 6, 7, 8, 9, 10, 11, 12, 13, 14, 15, 16, 16, 16, 17, 17, 18, 18, 18, 19, 19, 19, 20, 20, 20, 20, 21, 21, 21, 21, 22, 22, 22, 22, 22, 23, 23, 23, 23, 23, 23, 24, 24, 24, 24, 24, 24, 25, 25, 25, 25, 25, 25, 25, 26, 26, 26, 26, 26, 26, 26, 26, 27, 27, 27, 27, 27, 27, 27, 27, 27, 27, 28, 28, 28, 28, 28, 28, 28, 28, 28, 28, 29, 29, 29, 29, 29, 29, 29, 29, 29, 29, 29, 29, 30, 30, 30, 30, 30, 30, 30, 30, 30, 30, 30, 30, 30, 30, 31, 31, 31, 31, 31, 31, 31, 31, 31, 31, 31, 31, 31, 31, 31, 31, 31, 31, 31};

DI int otid() { int t = threadIdx.x; asm volatile("" : "+v"(t)); return t; }
DI u16 f2bf(float x) { unsigned u = __float_as_uint(x); u += 0x7fffu + ((u >> 16) & 1u); return (u16)(u >> 16); }
typedef __bf16 bf16x2_t __attribute__((ext_vector_type(2)));
typedef float f32x2_t __attribute__((ext_vector_type(2)));
DI unsigned pack2(float a, float b) { f32x2_t x = {a, b}; return __builtin_bit_cast(unsigned, __builtin_convertvector(x, bf16x2_t)); }
DI float bf2f(u16 v) { return __uint_as_float(((unsigned)v) << 16); }
DI float bflo(unsigned v) { return __uint_as_float(v << 16); }
DI float bfhi(unsigned v) { return __uint_as_float(v & 0xffff0000u); }
DI f32x16 mfma32(bf16x8 a, bf16x8 b, f32x16 c) { return __builtin_amdgcn_mfma_f32_32x32x16_bf16(a, b, c, 0, 0, 0); }
DI f32x16 zero16() { f32x16 z; for (int i = 0; i < 16; ++i) z[i] = 0.f; return z; }
DI f32x16 zero16v() { float zz = 0.f; asm volatile("" : "+v"(zz)); f32x16 z; for (int i = 0; i < 16; ++i) z[i] = zz; return z; }
DI s16x4 tr_read(const uchar* p) {
  return __builtin_amdgcn_ds_read_tr16_b64_v4i16((s16x4 __attribute__((address_space(3)))*)(p));
}
DI bf16x8 pack8(const f32x16& x, int s) {
  uint4 p;
  p.x = pack2(x[8 * s + 0], x[8 * s + 1]); p.y = pack2(x[8 * s + 2], x[8 * s + 3]);
  p.z = pack2(x[8 * s + 4], x[8 * s + 5]); p.w = pack2(x[8 * s + 6], x[8 * s + 7]);
  return __builtin_bit_cast(bf16x8, p);
}
DI float wave_sum(float v) { for (int o = 32; o > 0; o >>= 1) v += __shfl_xor(v, o, 64); return v; }
DI float wave_max(float v) { for (int o = 32; o > 0; o >>= 1) v = fmaxf(v, __shfl_xor(v, o, 64)); return v; }

typedef __bf16 bf2_t __attribute__((ext_vector_type(2)));
typedef float f32x2 __attribute__((ext_vector_type(2)));
DI float dot2bf(unsigned a, unsigned b, float c) { return __builtin_amdgcn_fdot2_f32_bf16(__builtin_bit_cast(bf2_t, a), __builtin_bit_cast(bf2_t, b), c, false); }
DI float red8(float v) {
  v += __builtin_amdgcn_update_dpp(0.f, v, 0xB1, 0xf, 0xf, true);
  v += __builtin_amdgcn_update_dpp(0.f, v, 0x4E, 0xf, 0xf, true);
  v += __builtin_amdgcn_update_dpp(0.f, v, 0x141, 0xf, 0xf, true);
  return v;
}
DI int wave_sum_i(int v) {
  v += __builtin_amdgcn_update_dpp(0, v, 0xB1, 0xf, 0xf, true);
  v += __builtin_amdgcn_update_dpp(0, v, 0x4E, 0xf, 0xf, true);
  v += __builtin_amdgcn_update_dpp(0, v, 0x141, 0xf, 0xf, true);
  v += __builtin_amdgcn_update_dpp(0, v, 0x140, 0xf, 0xf, true);
  return __builtin_amdgcn_readlane(v, 0) + __builtin_amdgcn_readlane(v, 16) + __builtin_amdgcn_readlane(v, 32) + __builtin_amdgcn_readlane(v, 48);
}

DI int next_item(unsigned* ctr, int* s_slot) {
  __syncthreads();
  if (threadIdx.x == 0) *s_slot = (int)atomicAdd(ctr, 1u);
  __syncthreads();
  return *s_slot;
}


DI int next_item_b(unsigned* q8, int per_batch, int& att, int& b, int* s_slot) {
  for (;;) {
    if (att >= 8) return -1;
    b = (int)((blockIdx.x + att) & 7);
    int it = next_item(q8 + b, s_slot);
    if (it < per_batch) return it;
    ++att;
  }
}

DI void stage64(uchar* dst, const u16* src, size_t row_stride) {
  const int tid = otid();
#pragma unroll
  for (int i = 0; i < 2; ++i) {
    int c = tid + 256 * i, row = c >> 3, kc = c & 7;
    uint4 v = *(const uint4*)(src + (size_t)row * row_stride + kc * 8);
    *(uint4*)(dst + row * 144 + kc * 16) = v;
  }
}

DI void qk_tile(f32x16 st[2], const bf16x8* qf, int s0, int ns, const uchar* Ks, int r31, int h) {
#pragma unroll
  for (int kt = 0; kt < 2; ++kt) {
    st[kt] = zero16();
#pragma unroll
    for (int s = 0; s < ns; ++s) {
      bf16x8 kf = *(const bf16x8*)(Ks + (32 * kt + r31) * 144 + (2 * (s0 + s) + h) * 16);
      st[kt] = mfma32(kf, qf[s0 + s], st[kt]);
    }
  }
}

DI void pv_tile(f32x16 O[2], const bf16x8 pf[4], const uchar* Vs, int lane) {
  const int h = lane >> 5, blk = (lane >> 4) & 1, q4 = (lane & 15) >> 2, p = lane & 3;
#pragma unroll
  for (int sp = 0; sp < 4; ++sp) {
#pragma unroll
    for (int dt = 0; dt < 2; ++dt) {
      const uchar* a = Vs + (16 * sp + 4 * h + q4) * 144 + 64 * dt + 32 * blk + 8 * p;
      s16x4 lo = tr_read(a), hi = tr_read(a + 8 * 144);
      bf16x8 vf = __builtin_shufflevector(lo, hi, 0, 1, 2, 3, 4, 5, 6, 7);
      O[dt] = mfma32(vf, pf[sp], O[dt]);
    }
  }
}

constexpr float LOG2E = 1.4426950408889634f;
template <int NO, bool COND>
DI void sm_rescale(float& m, float mx, float& lsum, f32x16* O) {
  if (!COND || __builtin_amdgcn_ballot_w64(mx > m) != 0ull) {
    const float corr = __builtin_amdgcn_exp2f(m - mx);
    lsum *= corr;
#pragma unroll
    for (int o = 0; o < NO; ++o)
#pragma unroll
      for (int i = 0; i < 16; ++i) O[o][i] *= corr;
  }
  m = mx;
}
DI float max16(const f32x16& x) {
  float a = fmaxf(fmaxf(x[0], x[1]), x[2]), b = fmaxf(fmaxf(x[3], x[4]), x[5]), c = fmaxf(fmaxf(x[6], x[7]), x[8]);
  float d = fmaxf(fmaxf(x[9], x[10]), x[11]), e = fmaxf(fmaxf(x[12], x[13]), x[14]);
  return fmaxf(fmaxf(fmaxf(a, b), fmaxf(c, d)), fmaxf(e, x[15]));
}
template <int NO, bool COND = true>
DI void softmax_step(f32x16 st[2], float& m, float& lsum, f32x16* O, bf16x8 pf[4]) {
  float mx = fmaxf(m, fmaxf(max16(st[0]), max16(st[1])));
  mx = fmaxf(mx, __shfl_xor(mx, 32, 64));
  sm_rescale<NO, COND>(m, mx, lsum, O);
#pragma unroll
  for (int kt = 0; kt < 2; ++kt)
#pragma unroll
    for (int i = 0; i < 16; ++i) { float p = __builtin_amdgcn_exp2f(st[kt][i] - mx); lsum += p; st[kt][i] = p; }
#pragma unroll
  for (int kt = 0; kt < 2; ++kt) { pf[2 * kt] = pack8(st[kt], 0); pf[2 * kt + 1] = pack8(st[kt], 1); }
}
template <int NO, bool COND = true>
DI void softmax_far(f32x16 st[2], float c2, float b2, float& m, float& lsum, f32x16* O, bf16x8 pf[4]) {
  float mr = fmaxf(max16(st[0]), max16(st[1]));
  float mx = fmaxf(m, mr * c2 + b2);
  mx = fmaxf(mx, __shfl_xor(mx, 32, 64));
  sm_rescale<NO, COND>(m, mx, lsum, O);
  const float off = b2 - mx;
#pragma unroll
  for (int kt = 0; kt < 2; ++kt)
#pragma unroll
    for (int i = 0; i < 16; ++i) { float p = __builtin_amdgcn_exp2f(__builtin_fmaf(st[kt][i], c2, off)); lsum += p; st[kt][i] = p; }
#pragma unroll
  for (int kt = 0; kt < 2; ++kt) { pf[2 * kt] = pack8(st[kt], 0); pf[2 * kt + 1] = pack8(st[kt], 1); }
}

DI int crow(int i, int h) { return (i & 3) + 8 * (i >> 2) + 4 * h; }

DI int colmap_in(int n) {
  if (n < 1344) return n;
  if (n < 1984) return n + 8;
  if (n < 3520) return n + 20;
  if (n < 3528) return 1344 + (n - 3520);
  if (n < 3540) return 1992 + (n - 3528);
  return -1;
}
DI void transpose_convert(const float* __restrict__ src, int K, int Nsrc, u16* __restrict__ dst, int Ndst, bool remap, uchar* smem, int Ntot = 0, int nofs = 0) {
  if (Ntot == 0) Ntot = Ndst;
  float* tile = (float*)smem;
  const int tid = otid();
  const int nkt = K / 64, ntiles = (Ndst / 64) * nkt;
  for (int t = blockIdx.x; t < ntiles; t += gridDim.x) {
    const int kt = t % nkt, nt = t / nkt;
    __syncthreads();
#pragma unroll 4
    for (int i = 0; i < 16; ++i) {
      int e = tid + 256 * i, r = e >> 6, c = e & 63;
      int n = nt * 64 + c;
      int sc = remap ? colmap_in(n) : n;
      float v = sc >= 0 ? src[(size_t)(kt * 64 + r) * Nsrc + sc] : 0.f;
      tile[r * 65 + c] = v;
    }
    __syncthreads();
#pragma unroll
    for (int i = 0; i < 2; ++i) {
      int e = tid + 256 * i, n = e >> 3, kc = e & 7;
      uint4 o;
      o.x = pack2(tile[(kc * 8 + 0) * 65 + n], tile[(kc * 8 + 1) * 65 + n]);
      o.y = pack2(tile[(kc * 8 + 2) * 65 + n], tile[(kc * 8 + 3) * 65 + n]);
      o.z = pack2(tile[(kc * 8 + 4) * 65 + n], tile[(kc * 8 + 5) * 65 + n]);
      o.w = pack2(tile[(kc * 8 + 6) * 65 + n], tile[(kc * 8 + 7) * 65 + n]);
      *(uint4*)(dst + ((size_t)(kt * 2 + (kc >> 2)) * Ntot + nofs + nt * 64 + n) * 32 + (kc & 3) * 8) = o;
    }
  }
}

DI void convert_layer_weights(const Params& P0_, int l, uchar* smem) {
  const KP P = kparams();
  uchar* ws = P.ws();
  transpose_convert(P.in(3) + (size_t)l * 1024 * IN_COLS, 1024, IN_COLS, (u16*)(ws + W_IN), HC, true, smem);
  transpose_convert(P.in(4) + (size_t)l * 1024 * 1024, 1024, 1024, (u16*)(ws + W_OUT), 1024, false, smem);
  transpose_convert(P.in(18) + (size_t)l * 1024 * 1024, 1024, 1024, (u16*)(ws + W_XQ), 1024, false, smem);
  transpose_convert(P.in(19) + (size_t)l * 1024 * 1024, 1024, 1024, (u16*)(ws + W_XK), 1024, false, smem, 2048, 0);
  transpose_convert(P.in(20) + (size_t)l * 1024 * 1024, 1024, 1024, (u16*)(ws + W_XK), 1024, false, smem, 2048, 1024);
  transpose_convert(P.in(21) + (size_t)l * 1024 * 1024, 1024, 1024, (u16*)(ws + W_XO), 1024, false, smem);
  transpose_convert(P.in(24) + (size_t)l * 1024 * DFF, 1024, DFF, (u16*)(ws + W_1), DFF, false, smem);
  transpose_convert(P.in(25) + (size_t)l * DFF * 1024, DFF, 1024, (u16*)(ws + W_2), 1024, false, smem);
}

DI size_t kblk(size_t M, size_t m, int k) { return ((size_t)(k >> 5) * M + m) * 32 + (k & 31); }
DI void convert_flat(const float* __restrict__ src, u16* __restrict__ dst, size_t n) {
  size_t nv = n / 8;
  for (size_t i = (size_t)blockIdx.x * NTHREADS + threadIdx.x; i < nv; i += (size_t)gridDim.x * NTHREADS) {
    float4 a = *(const float4*)(src + i * 8), b = *(const float4*)(src + i * 8 + 4);
    uint4 o; o.x = pack2(a.x, a.y); o.y = pack2(a.z, a.w); o.z = pack2(b.x, b.y); o.w = pack2(b.z, b.w);
    const size_t e = i * 8, m = e >> 10; const int k = (int)(e & 1023);
    *(uint4*)(dst + kblk(n >> 10, m, k)) = o;
  }
}

enum { EPI_BF16 = 0, EPI_RELU2 = 1, EPI_RESID = 2, EPI_QF = 3 };
struct LnArgs { const float* g; const float* b; float* fout; unsigned* flags; float2* stats; unsigned target; };
template <int EPI>
DI void gemm_tile256(const u16* __restrict__ A, int lda, const u16* __restrict__ Bt, int ldb, int K, int m0, int n0,
                     void* Cout, int ldc, const u16* Xres, uchar* smem, LnArgs ln = LnArgs{}) {
  const int tid = otid(), lane = tid & 63, wave = tid >> 6, wr = wave >> 1, wc = wave & 1, h = lane >> 5, r31 = lane & 31;
  f32x16 acc[4][2];
#pragma unroll
  for (int a = 0; a < 4; ++a)
#pragma unroll
    for (int b = 0; b < 2; ++b) acc[a][b] = zero16();
  const int nk = K / 32;
  constexpr int SB = 24576, BO = 16384;
  const int gc = (tid & 3) ^ ((tid >> 4) & 3);
  const u16* Ap = A + (size_t)(m0 + (tid >> 2)) * 32 + gc * 8;
  const u16* Bp = Bt + (size_t)(n0 + (tid >> 2)) * 32 + gc * 8;
#define STAGE(buf, ko) do { uchar* d_ = smem + (buf) * SB + tid * 16; \
    __builtin_amdgcn_global_load_lds((const unsigned*)(Ap + (size_t)(ko) * lda), (__attribute__((address_space(3))) unsigned*)(d_), 16, 0, 0); \
    __builtin_amdgcn_global_load_lds((const unsigned*)(Ap + (size_t)(ko) * lda + 64 * 32), (__attribute__((address_space(3))) unsigned*)(d_ + 4096), 16, 0, 0); \
    __builtin_amdgcn_global_load_lds((const unsigned*)(Ap + (size_t)(ko) * lda + 128 * 32), (__attribute__((address_space(3))) unsigned*)(d_ + 8192), 16, 0, 0); \
    __builtin_amdgcn_global_load_lds((const unsigned*)(Ap + (size_t)(ko) * lda + 192 * 32), (__attribute__((address_space(3))) unsigned*)(d_ + 12288), 16, 0, 0); \
    __builtin_amdgcn_global_load_lds((const unsigned*)(Bp + (size_t)(ko) * ldb), (__attribute__((address_space(3))) unsigned*)(d_ + 16384), 16, 0, 0); \
    __builtin_amdgcn_global_load_lds((const unsigned*)(Bp + (size_t)(ko) * ldb + 64 * 32), (__attribute__((address_space(3))) unsigned*)(d_ + 20480), 16, 0, 0); } while (0)
  const int fsw = (r31 >> 2) & 3;
  const int c0o = ((h) ^ fsw) * 16, c1o = ((2 + h) ^ fsw) * 16;
  const unsigned lds0 = (unsigned)(size_t)smem;
  const unsigned aoff = lds0 + (wr * 128 + r31) * 64, boff = lds0 + BO + (wc * 64 + r31) * 64;
#define COMPUTE(sbyte) do { \
      bf16x8 p0, p1, q0, q1, q2, q3, t0, t1, u0, u1, u2, u3; \
      const unsigned b0_ = boff + (sbyte) + c0o, a0_ = aoff + (sbyte) + c0o, b1_ = boff + (sbyte) + c1o, a1_ = aoff + (sbyte) + c1o; \
      asm volatile("ds_read_b128 %0, %12\n\tds_read_b128 %1, %12 offset:2048\n\t" \
                   "ds_read_b128 %2, %13\n\tds_read_b128 %3, %13 offset:2048\n\tds_read_b128 %4, %13 offset:4096\n\tds_read_b128 %5, %13 offset:6144\n\t" \
                   "ds_read_b128 %6, %14\n\tds_read_b128 %7, %14 offset:2048\n\t" \
                   "ds_read_b128 %8, %15\n\tds_read_b128 %9, %15 offset:2048\n\tds_read_b128 %10, %15 offset:4096\n\tds_read_b128 %11, %15 offset:6144\n\t" \
                   "s_waitcnt lgkmcnt(0)" \
                   : "=&v"(p0), "=&v"(p1), "=&v"(q0), "=&v"(q1), "=&v"(q2), "=&v"(q3), "=&v"(t0), "=&v"(t1), "=&v"(u0), "=&v"(u1), "=&v"(u2), "=&v"(u3) \
                   : "v"(b0_), "v"(a0_), "v"(b1_), "v"(a1_) : "memory"); \
      acc[0][0] = mfma32(p0, q0, acc[0][0]); acc[0][1] = mfma32(p1, q0, acc[0][1]); \
      acc[1][0] = mfma32(p0, q1, acc[1][0]); acc[1][1] = mfma32(p1, q1, acc[1][1]); \
      acc[2][0] = mfma32(p0, q2, acc[2][0]); acc[2][1] = mfma32(p1, q2, acc[2][1]); \
      acc[3][0] = mfma32(p0, q3, acc[3][0]); acc[3][1] = mfma32(p1, q3, acc[3][1]); \
      acc[0][0] = mfma32(t0, u0, acc[0][0]); acc[0][1] = mfma32(t1, u0, acc[0][1]); \
      acc[1][0] = mfma32(t0, u1, acc[1][0]); acc[1][1] = mfma32(t1, u1, acc[1][1]); \
      acc[2][0] = mfma32(t0, u2, acc[2][0]); acc[2][1] = mfma32(t1, u2, acc[2][1]); \
      acc[3][0] = mfma32(t0, u3, acc[3][0]); acc[3][1] = mfma32(t1, u3, acc[3][1]); \
      __builtin_amdgcn_sched_barrier(0); } while (0)
  __syncthreads();
  STAGE(0, 0);
  STAGE(1, 32);
  int cb = 0;
  for (int kt = 0; kt < nk; ++kt) {
    if (kt + 1 < nk) asm volatile("s_waitcnt vmcnt(6)" ::: "memory"); else asm volatile("s_waitcnt vmcnt(0)" ::: "memory");
    __builtin_amdgcn_s_barrier();
    __builtin_amdgcn_sched_barrier(0);
    if (kt + 2 < nk) { const int nb = cb >= 1 ? cb - 1 : 2; STAGE(nb, (kt + 2) * 32); }
    COMPUTE(cb * SB);
    cb = cb == 2 ? 0 : cb + 1;
  }
  __syncthreads();
#undef STAGE
#undef COMPUTE
  if (EPI == EPI_RESID) {
    const int mt = m0 >> 8, nt = n0 >> 7;
    float2* myst = ln.stats + (size_t)(mt * 8 + nt) * 256;
    float2* rowstat = (float2*)(smem + 67584);
#define STAGE_HALF(hf) do { if (wr == (hf)) { \
      _Pragma("unroll") for (int mi = 0; mi < 4; ++mi) _Pragma("unroll") for (int ni = 0; ni < 2; ++ni) _Pragma("unroll") for (int g = 0; g < 4; ++g) { \
        float4 v; v.x = acc[mi][ni][4 * g]; v.y = acc[mi][ni][4 * g + 1]; v.z = acc[mi][ni][4 * g + 2]; v.w = acc[mi][ni][4 * g + 3]; \
        *(float4*)(smem + (mi * 32 + r31) * 528 + (wc * 64 + ni * 32 + 8 * g + 4 * h) * 4) = v; } } \
      __syncthreads(); } while (0)
#pragma unroll
    for (int hf = 0; hf < 2; ++hf) {
      STAGE_HALF(hf);
#pragma unroll 4
      for (int i = 0; i < 16; ++i) {
        const int id = tid + 256 * i, row = (id >> 3) & 127, c = ((id >> 10) << 3) | (id & 7);
        float4* sp = (float4*)(smem + row * 528 + c * 16);
        const float4 v = *sp;
        const uint2 xb = *(const uint2*)(Xres + kblk(NT, (size_t)(m0 + hf * 128 + row), n0 + c * 4));
        float4 y; y.x = ALPHA * bflo(xb.x) + v.x; y.y = ALPHA * bfhi(xb.x) + v.y; y.z = ALPHA * bflo(xb.y) + v.z; y.w = ALPHA * bfhi(xb.y) + v.w;
        *sp = y;
      }
      __syncthreads();
      if (tid < 128) {
        float sa = 0.f, sq = 0.f;
#pragma unroll 8
        for (int c = 0; c < 32; ++c) {
          const float4 y = *(const float4*)(smem + tid * 528 + c * 16);
          sa += (y.x + y.y) + (y.z + y.w); sq += (y.x * y.x + y.y * y.y) + (y.z * y.z + y.w * y.w);
        }
        __hip_atomic_store((unsigned*)&myst[hf * 128 + tid].x, __float_as_uint(sa), __ATOMIC_RELAXED, __HIP_MEMORY_SCOPE_AGENT);
        __hip_atomic_store((unsigned*)&myst[hf * 128 + tid].y, __float_as_uint(sq), __ATOMIC_RELAXED, __HIP_MEMORY_SCOPE_AGENT);
      }
      __syncthreads();
    }
    asm volatile("s_waitcnt vmcnt(0)" ::: "memory");
    __syncthreads();
    if (threadIdx.x == 0) {
      (void)__hip_atomic_fetch_add(ln.flags + mt, 1u, __ATOMIC_RELAXED, __HIP_MEMORY_SCOPE_AGENT);
      unsigned sp = 0u;
      while (__hip_atomic_load(ln.flags + mt, __ATOMIC_RELAXED, __HIP_MEMORY_SCOPE_AGENT) < ln.target) { __builtin_amdgcn_s_sleep(1); if (++sp > (1u << 24)) break; }
    }
    __syncthreads();
    {
      float sa = 0.f, sq = 0.f;
#pragma unroll
      for (int k = 0; k < 8; ++k) {
        const float2* pp = ln.stats + (size_t)(mt * 8 + k) * 256 + tid;
        sa += __uint_as_float(__hip_atomic_load((const unsigned*)&pp->x, __ATOMIC_RELAXED, __HIP_MEMORY_SCOPE_AGENT));
        sq += __uint_as_float(__hip_atomic_load((const unsigned*)&pp->y, __ATOMIC_RELAXED, __HIP_MEMORY_SCOPE_AGENT));
      }
      const float mu = sa * (1.f / 1024.f);
      const float var = sq * (1.f / 1024.f) - mu * mu;
      rowstat[tid] = make_float2(mu, rsqrtf(fmaxf(var, 0.f) + 1e-5f));
    }
#pragma unroll
    for (int hf = 0; hf < 2; ++hf) {
      STAGE_HALF(hf);
#pragma unroll 4
      for (int i = 0; i < 16; ++i) {
        const int id = tid + 256 * i, row = (id >> 3) & 127, c = ((id >> 10) << 3) | (id & 7);
        const float4 v = *(const float4*)(smem + row * 528 + c * 16);
        const size_t go = kblk(NT, (size_t)(m0 + hf * 128 + row), n0 + c * 4);
        const uint2 xb = *(const uint2*)(Xres + go);
        const float2 rs = rowstat[hf * 128 + row];
        const float4 g4 = *(const float4*)(ln.g + n0 + c * 4), b4 = *(const float4*)(ln.b + n0 + c * 4);
        float4 o;
        o.x = (ALPHA * bflo(xb.x) + v.x - rs.x) * rs.y * g4.x + b4.x; o.y = (ALPHA * bfhi(xb.x) + v.y - rs.x) * rs.y * g4.y + b4.y;
        o.z = (ALPHA * bflo(xb.y) + v.z - rs.x) * rs.y * g4.z + b4.z; o.w = (ALPHA * bfhi(xb.y) + v.w - rs.x) * rs.y * g4.w + b4.w;
        uint2 ob; ob.x = pack2(o.x, o.y); ob.y = pack2(o.z, o.w);
        *(uint2*)((u16*)Xres + go) = ob;
        if (ln.fout) *(float4*)(ln.fout + (size_t)(m0 + hf * 128 + row) * ldc + n0 + c * 4) = o;
      }
      __syncthreads();
    }
#undef STAGE_HALF
  } else {
#pragma unroll
    for (int mi = 0; mi < 4; ++mi)
#pragma unroll
      for (int ni = 0; ni < 2; ++ni)
#pragma unroll
        for (int g = 0; g < 4; ++g) {
          float v0 = acc[mi][ni][4 * g], v1 = acc[mi][ni][4 * g + 1], v2 = acc[mi][ni][4 * g + 2], v3 = acc[mi][ni][4 * g + 3];
          if (EPI == EPI_RELU2) { v0 = fmaxf(v0, 0.f); v0 *= v0; v1 = fmaxf(v1, 0.f); v1 *= v1; v2 = fmaxf(v2, 0.f); v2 *= v2; v3 = fmaxf(v3, 0.f); v3 *= v3; }
          uint2 o; o.x = pack2(v0, v1); o.y = pack2(v2, v3);
          *(uint2*)(smem + (wr * 128 + mi * 32 + r31) * 272 + (wc * 64 + ni * 32 + 8 * g + 4 * h) * 2) = o;
        }
    __syncthreads();
#pragma unroll 4
    for (int i = 0; i < 16; ++i) {
      if (EPI == EPI_QF) {
        const int id = tid + 256 * i, ln64 = id & 63, ks = (id >> 6) & 7, kt8 = id >> 9;
        const uint4 v = *(const uint4*)(smem + (kt8 * 32 + (ln64 & 31)) * 272 + (2 * ks + (ln64 >> 5)) * 16);
        const size_t piece = ((size_t)((n0 >> 8) * (NT / 32) + (m0 >> 5) + kt8) * 16 + ((n0 & 255) >> 4) + ks) * 64 + ln64;
        *(uint4*)((u16*)Cout + piece * 8) = v;
      } else if (EPI == EPI_RELU2) {
        const int id = tid + 256 * i, row = (id >> 2) & 255, c = ((id >> 10) << 2) | (id & 3);
        const uint4 v = *(const uint4*)(smem + row * 272 + c * 16);
        *(uint4*)((u16*)Cout + kblk(NT, (size_t)(m0 + row), n0 + c * 8)) = v;
      } else {
      const int id = tid + 256 * i, row = id >> 4, c = id & 15;
      const uint4 v = *(const uint4*)(smem + row * 272 + c * 16);
      *(uint4*)((u16*)Cout + (size_t)(m0 + row) * ldc + n0 + c * 8) = v;
      }
    }
    if (EPI == EPI_BF16 && ldc == HC && n0 == A_KI && ln.stats) {
      u16* kif = (u16*)ln.stats;
#pragma unroll 4
      for (int i = 0; i < 8; ++i) {
        const int id = tid + 256 * i, ln64 = id & 63, ks = (id >> 6) & 3, kt8 = id >> 8;
        const uint4 v = *(const uint4*)(smem + (kt8 * 32 + (ln64 & 31)) * 272 + (2 * ks + (ln64 >> 5)) * 16);
        *(uint4*)(kif + ((size_t)(((m0 >> 5) + kt8) * 4 + ks) * 64 + ln64) * 8) = v;
      }
    }
    __syncthreads();
  }
}

template <int EPI>
DI void gemm_phase(const u16* A, int lda, const u16* Bt, int ldb, int M, int N, int K, void* C, int ldc, const u16* Xres, uchar* smem,
                           int xoff, LnArgs ln = LnArgs{}) {
  const int nN = N / 128, nM = M / 256;
  const int PC = (nN % 8 == 0) ? 8 : 4, PR = 64 / PC;
  const int npc = nN / PC, npatch = (nM / PR) * npc;
  const int x = (int)((blockIdx.x + 8 - xoff) & 7), j0 = (int)(blockIdx.x >> 3), slots = (int)(gridDim.x >> 3);
  for (int p = x; p < npatch; p += 8) {
    const int pr = p / npc, pc = p % npc;
    for (int j = j0; j < 64; j += slots) {
      const int mt = pr * PR + j / PC, nt = pc * PC + j % PC;
      gemm_tile256<EPI>(A, lda, Bt, ldb, K, mt * 256, nt * 128, C, ldc, Xres, smem, ln);
    }
  }
}

DI void ln_phase(float* __restrict__ Y, u16* __restrict__ Xb, const float* __restrict__ g, const float* __restrict__ bta, bool write_f32) {
  const int tid = otid(); const int lane = tid & 63, wave = tid >> 6;
  for (int row = blockIdx.x * 4 + wave; row < NT; row += gridDim.x * 4) {
    float* yr = Y + (size_t)row * DM;
    float4 v[4];
#pragma unroll
    for (int i = 0; i < 4; ++i) v[i] = *(const float4*)(yr + (i * 64 + lane) * 4);
    float s = 0.f;
#pragma unroll
    for (int i = 0; i < 4; ++i) s += v[i].x + v[i].y + v[i].z + v[i].w;
    s = wave_sum(s);
    const float mu = s * (1.f / DM);
    float q = 0.f;
#pragma unroll
    for (int i = 0; i < 4; ++i) { float a = v[i].x - mu, b = v[i].y - mu, c = v[i].z - mu, d = v[i].w - mu; q += a * a + b * b + c * c + d * d; }
    q = wave_sum(q);
    const float rstd = rsqrtf(q * (1.f / DM) + 1e-5f);
#pragma unroll
    for (int i = 0; i < 4; ++i) {
      const int c = (i * 64 + lane) * 4;
      float4 gg = *(const float4*)(g + c), bb = *(const float4*)(bta + c), o;
      o.x = (v[i].x - mu) * rstd * gg.x + bb.x; o.y = (v[i].y - mu) * rstd * gg.y + bb.y;
      o.z = (v[i].z - mu) * rstd * gg.z + bb.z; o.w = (v[i].w - mu) * rstd * gg.w + bb.w;
      if (write_f32) *(float4*)(yr + c) = o;
      uint2 ob; ob.x = pack2(o.x, o.y); ob.y = pack2(o.z, o.w);
      *(uint2*)(Xb + (size_t)row * DM + c) = ob;
    }
  }
}

DI void stage_bias(float* tab, const float* rel, int col) {
  for (int d = threadIdx.x; d < 132; d += NTHREADS) tab[d] = rel[BUCKET_LUT[d < 128 ? d : 128] * 16 + col] * LOG2E;
}
DI float bias_at(const float* tab, int dist) { int d = dist < 0 ? 0 : (dist > 128 ? 128 : dist); return tab[d]; }

DI void store_ot(u16* Ob, size_t tok0, int colbase, const f32x16 O[2], int lane, uchar* smem) {
  const int h = lane >> 5, r31 = lane & 31;
  uchar* stg = smem + 57344 + (otid() >> 6) * 4608;
#pragma unroll
  for (int dt = 0; dt < 2; ++dt)
#pragma unroll
    for (int g = 0; g < 4; ++g) {
      uint2 o; o.x = pack2(O[dt][4 * g], O[dt][4 * g + 1]); o.y = pack2(O[dt][4 * g + 2], O[dt][4 * g + 3]);
      *(uint2*)(stg + r31 * 144 + (32 * dt + 8 * g + 4 * h) * 2) = o;
    }
  asm volatile("s_waitcnt lgkmcnt(0)" ::: "memory");
#pragma unroll
  for (int i = 0; i < 4; ++i) {
    const int id = lane + 64 * i, row = (id >> 2) & 31, c = ((id >> 7) << 2) | (id & 3);
    const uint4 v = *(const uint4*)(stg + row * 144 + c * 16);
    *(uint4*)(Ob + kblk(NT, tok0 + row, colbase + c * 8)) = v;
  }
  asm volatile("s_waitcnt lgkmcnt(0)" ::: "memory");
}


#define KV_DECL uint4 pk0_, pk1_, pv0_, pv1_; const int kvr_ = tid >> 3, kvc_ = tid & 7
#define KV_LOAD(kp, vp, stride) do { const u16* kp_ = (kp) + (size_t)kvr_ * (stride) + kvc_ * 8; const u16* vp_ = (vp) + (size_t)kvr_ * (stride) + kvc_ * 8; \
    pk0_ = *(const uint4*)kp_; pk1_ = *(const uint4*)(kp_ + (size_t)32 * (stride)); pv0_ = *(const uint4*)vp_; pv1_ = *(const uint4*)(vp_ + (size_t)32 * (stride)); } while (0)
#define KV_STORE() do { uchar* d_ = Ks + kvr_ * 144 + kvc_ * 16; *(uint4*)d_ = pk0_; *(uint4*)(d_ + 32 * 144) = pk1_; \
    uchar* e_ = Vs + kvr_ * 144 + kvc_ * 16; *(uint4*)e_ = pv0_; *(uint4*)(e_ + 32 * 144) = pv1_; } while (0)

DI void diff_item(const Params& P0_, int l, int b, int item, uchar* smem) {
  const KP P = kparams();
  const u16* H = (const u16*)(P.ws() + OFF_H);
  u16* Ob = (u16*)(P.ws() + OFF_O);
  const int tid = otid(), lane = tid & 63, wave = tid >> 6, h = lane >> 5, r31 = lane & 31;
  const int qb = 31 - (item >> 2), hd = item & 3;
  const int q0 = qb * 128, qw0 = q0 + 32 * wave, qpos = qw0 + r31;
  uchar* Ks = smem; uchar* Vs = smem + 9216; float* tab = (float*)(smem + 18432);
  __syncthreads();
  stage_bias(tab, P.in(2), 12 + hd);
  float d1 = (lane < 32) ? P.in(11)[l * 32 + r31] * P.in(12)[l * 32 + r31] : 0.f;
  float d2 = (lane < 32) ? P.in(13)[l * 32 + r31] * P.in(14)[l * 32 + r31] : 0.f;
  d1 = wave_sum(d1); d2 = wave_sum(d2);
  const float lam_init = 0.8f - 0.6f * expf(-0.3f * (float)l);
  const float lam = expf(d1) - expf(d2) + lam_init;
  const size_t tokbase = (size_t)b * SL;
  bf16x8 qf[4];
  { const u16* qrow = H + (tokbase + qpos) * HC + D_Q + hd * 64;
#pragma unroll
    for (int s = 0; s < 4; ++s) qf[s] = *(const bf16x8*)(qrow + 16 * s + 8 * h); }
  f32x16 O0[2], O1[2];
  O0[0] = zero16(); O0[1] = zero16(); O1[0] = zero16(); O1[1] = zero16();
  float m0 = -1e30f, l0 = 0.f, m1 = -1e30f, l1 = 0.f;
  const float c2 = 0.17677669529663687f * LOG2E;
  const int nt = (q0 + 127) / 64 + 1;
  KV_DECL;
  KV_LOAD(H + tokbase * HC + D_K + hd * 64, H + tokbase * HC + D_V + hd * 64, HC);
  for (int t = 0; t < nt; ++t) {
    const int k0 = t * 64;
    __syncthreads();
    KV_STORE();
    __syncthreads();
    if (t + 1 < nt) KV_LOAD(H + (tokbase + k0 + 64) * HC + D_K + hd * 64, H + (tokbase + k0 + 64) * HC + D_V + hd * 64, HC);
    if (k0 <= qw0 + 31) {
      f32x16 st[2]; bf16x8 pf[4];
      const bool far = (qw0 - (k0 + 63)) >= 128;
      const float bfar = tab[128];
      qk_tile(st, qf, 0, 2, Ks, r31, h);
      if (far) {
        softmax_far<2>(st, c2, bfar, m0, l0, O0, pf);
      } else {
#pragma unroll
        for (int kt = 0; kt < 2; ++kt)
#pragma unroll
          for (int i = 0; i < 16; ++i) { int dist = qpos - (k0 + 32 * kt + crow(i, h)); st[kt][i] = dist >= 0 ? st[kt][i] * c2 + bias_at(tab, dist) : -INFINITY; }
        softmax_step<2>(st, m0, l0, O0, pf);
      }
      pv_tile(O0, pf, Vs, lane);
      qk_tile(st, qf, 2, 2, Ks, r31, h);
      if (far) {
        softmax_far<2>(st, c2, bfar, m1, l1, O1, pf);
      } else {
#pragma unroll
        for (int kt = 0; kt < 2; ++kt)
#pragma unroll
          for (int i = 0; i < 16; ++i) { int dist = qpos - (k0 + 32 * kt + crow(i, h)); st[kt][i] = dist >= 0 ? st[kt][i] * c2 + bias_at(tab, dist) : -INFINITY; }
        softmax_step<2>(st, m1, l1, O1, pf);
      }
      pv_tile(O1, pf, Vs, lane);
    }
  }
  l0 += __shfl_xor(l0, 32, 64); l1 += __shfl_xor(l1, 32, 64);
  const float i0 = 1.f / l0, i1 = lam / l1;
  float ss = 0.f;
#pragma unroll
  for (int dt = 0; dt < 2; ++dt)
#pragma unroll
    for (int i = 0; i < 16; ++i) { float v = O0[dt][i] * i0 - O1[dt][i] * i1; O0[dt][i] = v; ss += v * v; }
  ss += __shfl_xor(ss, 32, 64);
  const float rn = rsqrtf(ss * (1.f / 64.f) + 1e-6f) * (1.f - lam_init);
  const float* gp = P.in(15) + l * 64;
#pragma unroll
  for (int dt = 0; dt < 2; ++dt)
#pragma unroll
    for (int i = 0; i < 16; ++i) O0[dt][i] = O0[dt][i] * rn * gp[32 * dt + crow(i, h)];
  store_ot(Ob, tokbase + qw0, 768 + hd * 64, O0, lane, smem);
}

DI void moba_item(const Params& P0_, int b, int item, uchar* smem) {
  const KP P = kparams();
  const u16* H = (const u16*)(P.ws() + OFF_H);
  u16* Ob = (u16*)(P.ws() + OFF_O);
  const float* KM = (const float*)(P.ws() + OFF_KM);
  const int tid = otid(), lane = tid & 63, wave = tid >> 6, h = lane >> 5, r31 = lane & 31;
  const int qb = 31 - (item >> 2), hd = item & 3;
  const int q0 = qb * 128, qw0 = q0 + 32 * wave, qpos = qw0 + r31, cur = q0 >> 8;
  uchar* Ks = smem; uchar* Vs = smem + 9216; float* tab = (float*)(smem + 18432);
  float* kms = (float*)(smem + 18432 + 1024);
  unsigned* need = (unsigned*)(smem + 18432 + 1024 + 4096);
  __syncthreads();
  stage_bias(tab, P.in(2), 8 + hd);
  for (int i = tid; i < 16 * 64; i += NTHREADS) kms[i] = KM[((size_t)b * 16 + (i >> 6)) * 256 + hd * 64 + (i & 63)];
  if (tid == 0) *need = 0u;
  const size_t tokbase = (size_t)b * SL;
  bf16x8 qf[4];
  { const u16* qrow = H + (tokbase + qpos) * HC + C_Q + hd * 64;
#pragma unroll
    for (int s = 0; s < 4; ++s) qf[s] = *(const bf16x8*)(qrow + 16 * s + 8 * h); }
  __syncthreads();
  unsigned qmask = 0u;
  {
    float gate[16];
#pragma unroll
    for (int n = 0; n < 16; ++n) {
      float a = 0.f;
      if (n < cur) {
#pragma unroll
        for (int s = 0; s < 4; ++s)
#pragma unroll
          for (int j = 0; j < 8; ++j) a += bf2f((u16)qf[s][j]) * kms[n * 64 + 16 * s + 8 * h + j];
      }
      a += __shfl_xor(a, 32, 64);
      gate[n] = a;
    }
#pragma unroll
    for (int r = 0; r < 3; ++r) {
      float best = -INFINITY; int bi = -1;
#pragma unroll
      for (int n = 0; n < 16; ++n) if (n < cur && !((qmask >> n) & 1u) && gate[n] > best) { best = gate[n]; bi = n; }
      if (bi >= 0) qmask |= 1u << bi;
    }
    qmask |= 1u << cur;
  }
  unsigned wneed = 0u;
#pragma unroll
  for (int n = 0; n < 16; ++n) if (__builtin_amdgcn_ballot_w64((qmask >> n) & 1u) != 0ull) wneed |= 1u << n;
  if (lane == 0) atomicOr(need, wneed);
  __syncthreads();
  const unsigned bneed = *need;
  f32x16 O[2]; O[0] = zero16(); O[1] = zero16();
  float m = -1e30f, ls = 0.f;
  const float c2 = 0.125f * LOG2E;
  const int nt = (q0 + 127) / 64 + 1;
  KV_DECL;
  int t = 0;
  while (t < nt && !((bneed >> (t >> 2)) & 1u)) ++t;
  if (t < nt) KV_LOAD(H + (tokbase + t * 64) * HC + C_K + hd * 64, H + (tokbase + t * 64) * HC + C_V + hd * 64, HC);
  while (t < nt) {
    const int k0 = t * 64, jb = t >> 2;
    __syncthreads();
    KV_STORE();
    __syncthreads();
    int tn = t + 1;
    while (tn < nt && !((bneed >> (tn >> 2)) & 1u)) ++tn;
    if (tn < nt) KV_LOAD(H + (tokbase + tn * 64) * HC + C_K + hd * 64, H + (tokbase + tn * 64) * HC + C_V + hd * 64, HC);
    t = tn;
    if (((wneed >> jb) & 1u) && k0 <= qw0 + 31) {
      f32x16 st[2]; bf16x8 pf[4];
      qk_tile(st, qf, 0, 4, Ks, r31, h);
      const bool selq = (qmask >> jb) & 1u;
      if ((qw0 - (k0 + 63)) >= 128) {
        softmax_far<2>(st, c2, selq ? tab[128] : -INFINITY, m, ls, O, pf);
      } else {
#pragma unroll
        for (int kt = 0; kt < 2; ++kt)
#pragma unroll
          for (int i = 0; i < 16; ++i) {
            int dist = qpos - (k0 + 32 * kt + crow(i, h));
            st[kt][i] = (selq && dist >= 0) ? st[kt][i] * c2 + bias_at(tab, dist) : -INFINITY;
          }
        softmax_step<2>(st, m, ls, O, pf);
      }
      pv_tile(O, pf, Vs, lane);
    }
  }
  ls += __shfl_xor(ls, 32, 64);
  const float inv = ls > 0.f ? 1.f / ls : 0.f;
#pragma unroll
  for (int dt = 0; dt < 2; ++dt)
#pragma unroll
    for (int i = 0; i < 16; ++i) O[dt][i] *= inv;
  store_ot(Ob, tokbase + qw0, 512 + hd * 64, O, lane, smem);
}

DI void nsa_item(const Params& P0_, int b, int item, uchar* smem) {
  const KP P = kparams();
  const u16* H = (const u16*)(P.ws() + OFF_H);
  u16* Ob = (u16*)(P.ws() + OFF_O);
  const u16* KC = (const u16*)(P.ws() + OFF_KC);
  const u16* VC = (const u16*)(P.ws() + OFF_VC);
  const int tid = otid(), lane = tid & 63, wave = tid >> 6, h = lane >> 5, r31 = lane & 31;
  const int qb = 127 - item;
  const int q0 = qb * 32, qpos = q0 + r31, cur = q0 >> 6;
  uchar* Ks = smem; uchar* Vs = smem + 9216;
  float* tabs = (float*)(smem + 18432);
  float* imp = (float*)(smem + 18432 + 2112);
  unsigned* selm = (unsigned*)(smem + 18432 + 2112 + 32768);
  __syncthreads();
  for (int i = tid; i < 4 * 132; i += NTHREADS) { int w = i / 132, d = i % 132; tabs[i] = P.in(2)[BUCKET_LUT[d < 128 ? d : 128] * 16 + 4 + w] * LOG2E; }
  if (tid < 64) selm[tid] = 0u;
  const float* tab = tabs + wave * 132;
  const size_t tokbase = (size_t)b * SL;
  bf16x8 qf[4];
  { const u16* qrow = H + (tokbase + qpos) * HC + B_Q + wave * 64;
#pragma unroll
    for (int s = 0; s < 4; ++s) qf[s] = *(const bf16x8*)(qrow + 16 * s + 8 * h); }
  const float c2 = 0.125f * LOG2E;
  f32x16 acc[2];
  const u16* gp = H + (tokbase + qpos) * HC + B_G + wave * 3;
  {
    f32x16 O[4]; O[0] = zero16(); O[1] = zero16(); O[2] = zero16(); O[3] = zero16();
    float m = -1e30f, ls = 0.f;
    const int nmax = q0 / 16;
    const int ntl = (q0 >= 0 ? nmax / 64 + 1 : 0);
    for (int t = 0; t < ntl; ++t) {
      const int n0 = t * 64;
      __syncthreads();
      stage64(Ks, KC + ((size_t)b * 256 + n0) * 64, 64);
      stage64(Vs, VC + ((size_t)b * 256 + n0) * 64, 64);
      __syncthreads();
      f32x16 st[2]; bf16x8 pf[4];
      qk_tile(st, qf, 0, 4, Ks, r31, h);
#pragma unroll
      for (int kt = 0; kt < 2; ++kt)
#pragma unroll
        for (int i = 0; i < 16; ++i) {
          int n = n0 + 32 * kt + crow(i, h);
          st[kt][i] = (16 * n + 31 <= qpos) ? st[kt][i] * c2 : -INFINITY;
        }
      softmax_step<4, false>(st, m, ls, O, pf);
      pv_tile(O, pf, Vs, lane);
#pragma unroll
      for (int sp = 0; sp < 4; ++sp) {
#pragma unroll
        for (int u = 0; u < 2; ++u) {
          const int j = 32 * u + r31;
          bf16x8 of;
#pragma unroll
          for (int jj = 0; jj < 8; ++jj) {
            int n = n0 + 16 * sp + 8 * (jj >> 2) + 4 * h + (jj & 3);
            of[jj] = (n >= 4 * j - 1 && n <= 4 * j + 3) ? (short)0x3F80 : (short)0;
          }
          O[2 + u] = mfma32(of, pf[sp], O[2 + u]);
        }
      }
    }
    ls += __shfl_xor(ls, 32, 64);
    const float inv = ls > 0.f ? 1.f / ls : 0.f;
    const float ginv = inv / (1.f + __expf(-bf2f(gp[0])));
#pragma unroll
    for (int dt = 0; dt < 2; ++dt)
#pragma unroll
      for (int i = 0; i < 16; ++i) acc[dt][i] = ginv * O[dt][i];
#pragma unroll
    for (int u = 0; u < 2; ++u)
#pragma unroll
      for (int i = 0; i < 16; ++i) imp[(wave * 32 + r31) * 64 + 32 * u + crow(i, h)] = O[2 + u][i] * inv;
  }
  __syncthreads();
  {
    const int q = tid >> 3, jp = tid & 7, qp = q0 + q;
    float* row = imp + q * 64;
    float sv[8];
#pragma unroll
    for (int k = 0; k < 8; ++k) { int j = jp * 8 + k; sv[k] = imp[(0 * 32 + q) * 64 + j] + imp[(1 * 32 + q) * 64 + j] + imp[(2 * 32 + q) * 64 + j] + imp[(3 * 32 + q) * 64 + j]; }
    __syncthreads();
#pragma unroll
    for (int k = 0; k < 8; ++k) {
      int j = jp * 8 + k; float v = sv[k];
      if (j == 0 || j == cur || j == cur - 1) v = INFINITY;
      if (j * 64 > qp) v = -INFINITY;
      row[j] = v;
    }
    __syncthreads();
    unsigned bits = 0u;
#pragma unroll
    for (int k = 0; k < 8; ++k) {
      int j = jp * 8 + k; float v = row[j];
      int rank = 0;
      for (int j2 = 0; j2 < 64; ++j2) { float v2 = row[j2]; rank += (v2 > v || (v2 == v && j2 < j)) ? 1 : 0; }
      if (rank < 16 && j <= cur) bits |= 1u << k;
    }
    if (bits) atomicOr(&selm[q * 2 + (jp >> 2)], bits << ((jp & 3) * 8));
  }
  __syncthreads();
  const unsigned my_lo = selm[r31 * 2], my_hi = selm[r31 * 2 + 1];
  unsigned un_lo = 0u, un_hi = 0u;
  for (int q = 0; q < 32; ++q) { un_lo |= selm[q * 2]; un_hi |= selm[q * 2 + 1]; }
  KV_DECL;
  {
    f32x16 O[2]; O[0] = zero16v(); O[1] = zero16v();
    float m = -1e30f, ls = 0.f;
    const unsigned long long un = ((unsigned long long)un_hi << 32) | un_lo;
    int j = 0;
    while (j <= cur && !((un >> j) & 1ull)) ++j;
    if (j <= cur) KV_LOAD(H + (tokbase + j * 64) * HC + B_KS, H + (tokbase + j * 64) * HC + B_VS, HC);
    for (; j <= cur;) {
      const int k0 = j * 64;
      __syncthreads();
      KV_STORE();
      __syncthreads();
      int jn = j + 1;
      while (jn <= cur && !((un >> jn) & 1ull)) ++jn;
      if (jn <= cur) KV_LOAD(H + (tokbase + jn * 64) * HC + B_KS, H + (tokbase + jn * 64) * HC + B_VS, HC);
      const int jc = j; j = jn;
      const bool selq = jc < 32 ? ((my_lo >> jc) & 1u) : ((my_hi >> (jc - 32)) & 1u);
      f32x16 st[2]; bf16x8 pf[4];
      qk_tile(st, qf, 0, 4, Ks, r31, h);
      if ((q0 - (k0 + 63)) >= 128) {
        softmax_far<2, false>(st, c2, selq ? tab[128] : -INFINITY, m, ls, O, pf);
      } else {
#pragma unroll
        for (int kt = 0; kt < 2; ++kt)
#pragma unroll
          for (int i = 0; i < 16; ++i) {
            int dist = qpos - (k0 + 32 * kt + crow(i, h));
            st[kt][i] = (selq && dist >= 0) ? st[kt][i] * c2 + bias_at(tab, dist) : -INFINITY;
          }
        softmax_step<2, false>(st, m, ls, O, pf);
      }
      pv_tile(O, pf, Vs, lane);
    }
    ls += __shfl_xor(ls, 32, 64);
    const float inv = ls > 0.f ? 1.f / ls : 0.f;
    const float ginv = inv / (1.f + __expf(-bf2f(gp[1])));
#pragma unroll
    for (int dt = 0; dt < 2; ++dt)
#pragma unroll
      for (int i = 0; i < 16; ++i) acc[dt][i] += ginv * O[dt][i];
  }
  {
    f32x16 O[2]; O[0] = zero16v(); O[1] = zero16v();
    float m = -1e30f, ls = 0.f;
    int tlo = q0 - 511; tlo = tlo < 0 ? 0 : tlo >> 6;
    KV_LOAD(H + (tokbase + tlo * 64) * HC + B_KW, H + (tokbase + tlo * 64) * HC + B_VW, HC);
    for (int t = tlo; t <= cur; ++t) {
      const int k0 = t * 64;
      __syncthreads();
      KV_STORE();
      __syncthreads();
      if (t < cur) KV_LOAD(H + (tokbase + k0 + 64) * HC + B_KW, H + (tokbase + k0 + 64) * HC + B_VW, HC);
      f32x16 st[2]; bf16x8 pf[4];
      qk_tile(st, qf, 0, 4, Ks, r31, h);
      if ((q0 - (k0 + 63)) >= 128 && (q0 + 31 - k0) < 512) {
        softmax_far<2, false>(st, c2, tab[128], m, ls, O, pf);
      } else {
#pragma unroll
        for (int kt = 0; kt < 2; ++kt)
#pragma unroll
          for (int i = 0; i < 16; ++i) {
            int dist = qpos - (k0 + 32 * kt + crow(i, h));
            st[kt][i] = (dist >= 0 && dist < 512) ? st[kt][i] * c2 + bias_at(tab, dist) : -INFINITY;
          }
        softmax_step<2, false>(st, m, ls, O, pf);
      }
      pv_tile(O, pf, Vs, lane);
    }
    ls += __shfl_xor(ls, 32, 64);
    const float inv = ls > 0.f ? 1.f / ls : 0.f;
    const float ginv2 = inv / (1.f + __expf(-bf2f(gp[2])));
#pragma unroll
    for (int dt = 0; dt < 2; ++dt)
#pragma unroll
      for (int i = 0; i < 16; ++i) acc[dt][i] += ginv2 * O[dt][i];
  }
  store_ot(Ob, tokbase + q0, 256 + wave * 64, acc, lane, smem);
}

DI float gelu_tanh(float x) { float u = 0.7978845608028654f * (x + 0.044715f * x * x * x); return 0.5f * x * (1.f + tanhf(u)); }
DI void compress_item(const Params& P0_, int l, int item, uchar* smem) {
  const KP P = kparams();
  const u16* H = (const u16*)(P.ws() + OFF_H);
  const int tid = otid();
  const int which = item & 1, rest = item >> 1, b = rest & 7, grp = rest >> 3;
  const int nb = grp * 5;
  float* A = (float*)smem;
  float* part = (float*)(smem + 40960);
  float* gl = (float*)(smem + 40960 + 5120);
  const float* pos = P.in(which ? 6 : 5) + (size_t)l * 2048;
  const float* w1 = P.in(which ? 9 : 7) + (size_t)l * 2048 * 64;
  const float* w2 = P.in(which ? 10 : 8) + (size_t)l * 64 * 64;
  const int col = which ? B_VC : B_KC;
  __syncthreads();
  for (int e = tid; e < 5 * 2048; e += NTHREADS) {
    int r = e >> 11, k = e & 2047, t = k >> 6, d = k & 63;
    int tok = 16 * (nb + r) + t;
    A[e] = bf2f(H[((size_t)b * SL + tok) * HC + col + d]) + pos[k];
  }
  __syncthreads();
  const int j = tid & 63, pt = tid >> 6;
  float a[5] = {0.f, 0.f, 0.f, 0.f, 0.f};
  for (int k = pt * 512; k < pt * 512 + 512; ++k) {
    float wv = w1[(size_t)k * 64 + j];
#pragma unroll
    for (int r = 0; r < 5; ++r) a[r] += A[r * 2048 + k] * wv;
  }
#pragma unroll
  for (int r = 0; r < 5; ++r) part[(pt * 5 + r) * 64 + j] = a[r];
  __syncthreads();
  for (int e = tid; e < 320; e += NTHREADS) {
    int r = e >> 6, jj = e & 63;
    float s = part[(0 * 5 + r) * 64 + jj] + part[(1 * 5 + r) * 64 + jj] + part[(2 * 5 + r) * 64 + jj] + part[(3 * 5 + r) * 64 + jj];
    gl[r * 64 + jj] = gelu_tanh(s);
  }
  __syncthreads();
  u16* dst = (u16*)(P.ws() + (which ? OFF_VC : OFF_KC));
  for (int e = tid; e < 320; e += NTHREADS) {
    int r = e >> 6, jj = e & 63;
    float s = 0.f;
    for (int i = 0; i < 64; ++i) s += gl[r * 64 + i] * w2[i * 64 + jj];
    dst[((size_t)b * 256 + nb + r) * 64 + jj] = f2bf(s);
  }
  if (grp == 50) { for (int e = tid; e < 64; e += NTHREADS) dst[((size_t)b * 256 + 255) * 64 + e] = 0; }
}
DI void kmean_item(const Params& P0_, int item, uchar* smem) {
  const KP P = kparams();
  const u16* H = (const u16*)(P.ws() + OFF_H);
  float* KM = (float*)(P.ws() + OFF_KM);
  const int tid = otid(), lane = tid & 63, wave = tid >> 6;
  const int b = item >> 4, blk = item & 15;
  float* part = (float*)smem;
  float a0 = 0.f, a1 = 0.f, a2 = 0.f, a3 = 0.f;
  const u16* p = H + ((size_t)b * SL + blk * 256 + wave * 64) * HC + C_K + lane * 4;
#pragma unroll 16
  for (int t = 0; t < 64; ++t) {
    uint2 v = *(const uint2*)(p + (size_t)t * HC);
    a0 += bflo(v.x); a1 += bfhi(v.x); a2 += bflo(v.y); a3 += bfhi(v.y);
  }
  __syncthreads();
  part[wave * 256 + lane * 4 + 0] = a0; part[wave * 256 + lane * 4 + 1] = a1; part[wave * 256 + lane * 4 + 2] = a2; part[wave * 256 + lane * 4 + 3] = a3;
  __syncthreads();
  KM[((size_t)b * 16 + blk) * 256 + tid] = (part[tid] + part[256 + tid] + part[512 + tid] + part[768 + tid]) * (1.f / 256.f);
}

DI unsigned sortable(float f) { unsigned u = __float_as_uint(f); return (u & 0x80000000u) ? ~u : (u | 0x80000000u); }
DI void dsa_item(const Params& P0_, int b, int item, uchar* smem) {
  const KP P = kparams();
  const u16* H = (const u16*)(P.ws() + OFF_H);
  u16* Ob = (u16*)(P.ws() + OFF_O);
  const int tid = otid(), lane = tid & 63, wave = tid >> 6, h = lane >> 5, r31 = lane & 31;
  const int qb = 1023 - item;
  const int q0 = qb * 4;
  const size_t tokbase = (size_t)b * SL;
  float* sc = (float*)smem;
  u16* sel = (u16*)(smem + 65536);
  float* tabs = (float*)(smem + 65536 + 2048);
  __syncthreads();
  {
    const int hidx = (r31 & 3) | (((r31 >> 3) & 1) << 2), ql = ((r31 >> 2) & 1) | (((r31 >> 4) & 1) << 1);
    bf16x8 af[4];
    const u16* arow = H + (tokbase + q0 + ql) * HC + A_QI + hidx * 64;
#pragma unroll
    for (int s = 0; s < 4; ++s) af[s] = *(const bf16x8*)(arow + 16 * s + 8 * h);
    float wa[8], wb[8];
    { const uint4 va = *(const uint4*)(H + (tokbase + q0 + h) * HC + A_W), vb = *(const uint4*)(H + (tokbase + q0 + h + 2) * HC + A_W);
      wa[0] = bflo(va.x); wa[1] = bfhi(va.x); wa[2] = bflo(va.y); wa[3] = bfhi(va.y); wa[4] = bflo(va.z); wa[5] = bfhi(va.z); wa[6] = bflo(va.w); wa[7] = bfhi(va.w);
      wb[0] = bflo(vb.x); wb[1] = bfhi(vb.x); wb[2] = bflo(vb.y); wb[3] = bfhi(vb.y); wb[4] = bflo(vb.z); wb[5] = bfhi(vb.z); wb[6] = bflo(vb.w); wb[7] = bfhi(vb.w); }
    const int nkt = (q0 + 3) / 32 + 1;
    const u16* KIF = (const u16*)(P.ws() + OFF_KIF);
    bf16x8 k0f, k1f, k2f, k3f;
    {
      const int c0 = wave < nkt ? wave : 0;
      const u16* krow = KIF + ((size_t)((tokbase >> 5) + c0) * 256 + lane) * 8;
      k0f = *(const bf16x8*)(krow); k1f = *(const bf16x8*)(krow + 512); k2f = *(const bf16x8*)(krow + 1024); k3f = *(const bf16x8*)(krow + 1536);
    }
    for (int c = wave; c < nkt; c += 4) {
      bf16x8 n0f = k0f, n1f = k1f, n2f = k2f, n3f = k3f;
      if (c + 4 < nkt) {
        const u16* krow = KIF + ((size_t)((tokbase >> 5) + c + 4) * 256 + lane) * 8;
        n0f = *(const bf16x8*)(krow); n1f = *(const bf16x8*)(krow + 512); n2f = *(const bf16x8*)(krow + 1024); n3f = *(const bf16x8*)(krow + 1536);
      }
      f32x16 a = zero16();
      a = mfma32(af[0], k0f, a); a = mfma32(af[1], k1f, a); a = mfma32(af[2], k2f, a); a = mfma32(af[3], k3f, a);
      float sa = 0.f, sb = 0.f;
#pragma unroll
      for (int i = 0; i < 8; ++i) { sa += fmaxf(a[i], 0.f) * wa[i]; sb += fmaxf(a[8 + i], 0.f) * wb[i]; }
      sc[h * 4096 + 32 * c + r31] = sa;
      sc[(h + 2) * 4096 + 32 * c + r31] = sb;
      k0f = n0f; k1f = n1f; k2f = n2f; k3f = n3f;
    }
  }
  __syncthreads();
  const int qpos = q0 + wave, nvalid = qpos + 1;
  int count;
  unsigned long long myw = 0ull;
  if (nvalid <= 256) {
    count = nvalid;
    const int rem = nvalid - 64 * lane;
    myw = rem >= 64 ? ~0ull : (rem <= 0 ? 0ull : ((1ull << rem) - 1ull));
  } else {
    unsigned u[64];
#pragma unroll
    for (int c = 0; c < 64; ++c) { int s = lane + 64 * c; u[c] = (s < nvalid) ? sortable(sc[wave * 4096 + s]) : 0u; }
    const int ng = (nvalid + 1023) >> 10;
    unsigned T = 0u;
    bool exact = false;
    for (int bit = 31; bit >= 0; --bit) {
      const unsigned cand = T | (1u << bit);
      int lc = 0;
#pragma unroll
      for (int g = 0; g < 4; ++g) {
        if (g < ng) {
#pragma unroll
          for (int c = 16 * g; c < 16 * g + 16; ++c) lc += (u[c] >= cand) ? 1 : 0;
        }
      }
      const int cnt = wave_sum_i(lc);
      if (cnt >= 256) T = cand;
      if (cnt == 256) { exact = true; break; }
    }
    if (exact) {
#pragma unroll
      for (int g = 0; g < 4; ++g) {
        if (g < ng) {
#pragma unroll
          for (int c = 16 * g; c < 16 * g + 16; ++c) { const unsigned long long bt = __builtin_amdgcn_ballot_w64(u[c] >= T); if (lane == c) myw = bt; }
        }
      }
    } else {
      int cgt = 0;
#pragma unroll
      for (int c = 0; c < 64; ++c) cgt += __builtin_popcountll(__builtin_amdgcn_ballot_w64(u[c] > T));
      const int need_eq = 256 - cgt;
      int eq_seen = 0;
#pragma unroll
      for (int c = 0; c < 64; ++c) {
        const bool gt = u[c] > T, eq = u[c] == T;
        const unsigned long long beq = __builtin_amdgcn_ballot_w64(eq);
        const int erank = eq_seen + (int)__builtin_amdgcn_mbcnt_hi((unsigned)(beq >> 32), __builtin_amdgcn_mbcnt_lo((unsigned)beq, 0u));
        const bool take = gt || (eq && erank < need_eq);
        const unsigned long long bt = __builtin_amdgcn_ballot_w64(take);
        if (lane == c) myw = bt;
        eq_seen += __builtin_popcountll(beq);
      }
    }
    count = 256;
  }
  (void)count;
  ((unsigned long long*)(P.ws() + OFF_SEL))[(tokbase + qpos) * 64 + lane] = myw;
}

DI void dsa_dense_item(const Params& P0_, int b, int item, uchar* smem) {
  const KP P = kparams();
  const u16* H = (const u16*)(P.ws() + OFF_H);
  u16* Ob = (u16*)(P.ws() + OFF_O);
  const int tid = otid(), lane = tid & 63, wave = tid >> 6, h = lane >> 5, r31 = lane & 31;
  const int qb = 31 - (item >> 2), hd = item & 3;
  const int q0 = qb * 128, qw0 = q0 + 32 * wave, qpos = qw0 + r31;
  uchar* Ks = smem; uchar* Vs = smem + 9216; float* tab = (float*)(smem + 18432);
  __syncthreads();
  stage_bias(tab, P.in(2), hd);
  const size_t tokbase = (size_t)b * SL;
  bf16x8 qf[4];
  { const u16* qrow = H + (tokbase + qpos) * HC + A_Q + hd * 64;
#pragma unroll
    for (int s = 0; s < 4; ++s) qf[s] = *(const bf16x8*)(qrow + 16 * s + 8 * h); }
  const unsigned long long* mrow = (const unsigned long long*)(P.ws() + OFF_SEL) + (tokbase + qpos) * 64;
  f32x16 O[2]; O[0] = zero16(); O[1] = zero16();
  float m = -1e30f, ls = 0.f;
  const float c2 = 0.125f * LOG2E;
  const int nt = (q0 + 127) / 64 + 1;
  KV_DECL;
  KV_LOAD(H + tokbase * HC + A_K + hd * 64, H + tokbase * HC + A_V + hd * 64, HC);
  unsigned long long mw = mrow[0];
  for (int t = 0; t < nt; ++t) {
    const int k0 = t * 64;
    __syncthreads();
    KV_STORE();
    __syncthreads();
    const unsigned long long mcur = mw;
    if (t + 1 < nt) { KV_LOAD(H + (tokbase + k0 + 64) * HC + A_K + hd * 64, H + (tokbase + k0 + 64) * HC + A_V + hd * 64, HC); mw = mrow[t + 1]; }
    if (k0 <= qw0 + 31) {
      f32x16 st[2]; bf16x8 pf[4];
      qk_tile(st, qf, 0, 4, Ks, r31, h);
      const unsigned mlo = (unsigned)mcur, mhi = (unsigned)(mcur >> 32);
      if ((qw0 - (k0 + 63)) >= 128) {
        const float bfar = tab[128];
#pragma unroll
        for (int kt = 0; kt < 2; ++kt)
#pragma unroll
          for (int i = 0; i < 16; ++i) {
            const unsigned mm = kt ? mhi : mlo;
            st[kt][i] = ((mm >> crow(i, h)) & 1u) ? st[kt][i] * c2 + bfar : -INFINITY;
          }
      } else {
#pragma unroll
        for (int kt = 0; kt < 2; ++kt)
#pragma unroll
          for (int i = 0; i < 16; ++i) {
            const unsigned mm = kt ? mhi : mlo;
            const int dist = qpos - (k0 + 32 * kt + crow(i, h));
            st[kt][i] = ((mm >> crow(i, h)) & 1u) ? st[kt][i] * c2 + bias_at(tab, dist) : -INFINITY;
          }
      }
      softmax_step<2>(st, m, ls, O, pf);
      pv_tile(O, pf, Vs, lane);
    }
  }
  ls += __shfl_xor(ls, 32, 64);
  const float inv = ls > 0.f ? 1.f / ls : 0.f;
#pragma unroll
  for (int dt = 0; dt < 2; ++dt)
#pragma unroll
    for (int i = 0; i < 16; ++i) O[dt][i] *= inv;
  store_ot(Ob, tokbase + qw0, hd * 64, O, lane, smem);
}

DI void dsa_gather_item(const Params& P0_, int b, int item, uchar* smem) {
  const KP P = kparams();
  const u16* H = (const u16*)(P.ws() + OFF_H);
  u16* Ob = (u16*)(P.ws() + OFF_O);
  const int tid = otid(), lane = tid & 63, wave = tid >> 6, l7 = lane & 7, kg = lane >> 3;
  const int hd = item >> 8, qg = 255 - (item & 255);
  const size_t tokbase = (size_t)b * SL;
  float* tab = (float*)smem;
  u16* selw = (u16*)(smem + 1024 + wave * 2048);
  float* plw = (float*)(smem + 1024 + wave * 2048 + 512);
  u16* pbw = (u16*)(smem + 1024 + wave * 2048 + 1536);
  __syncthreads();
  stage_bias(tab, P.in(2), hd);
  __syncthreads();
  const u16* kb = H + tokbase * HC + A_K + hd * 64 + l7 * 8;
  const u16* vb = H + tokbase * HC + A_V + hd * 64 + l7 * 8;
  for (int qi = 0; qi < 4; ++qi) {
    const int qpos = qg * 16 + wave * 4 + qi;
    const int count = qpos + 1 < 256 ? qpos + 1 : 256;
    {
      const u16* gsel = (const u16*)(P.ws() + OFF_SEL) + (tokbase + qpos) * 256;
      *(uint2*)(selw + lane * 4) = *(const uint2*)(gsel + lane * 4);
    }
    asm volatile("s_waitcnt lgkmcnt(0)" ::: "memory");
    const uint4 qv = *(const uint4*)(H + (tokbase + qpos) * HC + A_Q + hd * 64 + l7 * 8);
#pragma unroll 8
    for (int i = 0; i < 32; ++i) {
      const int kk = 8 * i + kg;
      const int idx = selw[kk];
      const uint4 kv = *(const uint4*)(kb + (size_t)idx * HC);
      float d = dot2bf(kv.x, qv.x, 0.f); d = dot2bf(kv.y, qv.y, d); d = dot2bf(kv.z, qv.z, d); d = dot2bf(kv.w, qv.w, d);
      d = red8(d);
      if (l7 == 0) plw[kk] = d;
    }
    {
      float lg[4];
#pragma unroll
      for (int c = 0; c < 4; ++c) { const int kk = lane + 64 * c; lg[c] = (kk < count) ? plw[kk] * (0.125f * LOG2E) + bias_at(tab, qpos - (int)selw[kk]) : -INFINITY; }
      float mx = fmaxf(fmaxf(lg[0], lg[1]), fmaxf(lg[2], lg[3]));
      mx = wave_max(mx);
      float sm = 0.f;
#pragma unroll
      for (int c = 0; c < 4; ++c) { lg[c] = __builtin_amdgcn_exp2f(lg[c] - mx); sm += lg[c]; }
      sm = wave_sum(sm);
      const float inv = 1.f / sm;
#pragma unroll
      for (int c = 0; c < 4; ++c) pbw[lane + 64 * c] = f2bf(lg[c] * inv);
    }
    asm volatile("s_waitcnt lgkmcnt(0)" ::: "memory");
    float a0 = 0.f, a1 = 0.f, a2 = 0.f, a3 = 0.f, a4 = 0.f, a5 = 0.f, a6 = 0.f, a7 = 0.f;
    const int nb = (count + 15) >> 4;
    const unsigned* sel32 = (const unsigned*)selw;
    const unsigned* pb32 = (const unsigned*)pbw;
#pragma unroll 4
    for (int i = 0; i < nb; ++i) {
      const int kp = 8 * i + kg;
      const unsigned ii = sel32[kp], pp = pb32[kp];
      const uint4 x = *(const uint4*)(vb + (size_t)(ii & 0xffffu) * HC);
      const uint4 y = *(const uint4*)(vb + (size_t)(ii >> 16) * HC);
      a0 = dot2bf(__builtin_amdgcn_perm(y.x, x.x, 0x05040100u), pp, a0); a1 = dot2bf(__builtin_amdgcn_perm(y.x, x.x, 0x07060302u), pp, a1);
      a2 = dot2bf(__builtin_amdgcn_perm(y.y, x.y, 0x05040100u), pp, a2); a3 = dot2bf(__builtin_amdgcn_perm(y.y, x.y, 0x07060302u), pp, a3);
      a4 = dot2bf(__builtin_amdgcn_perm(y.z, x.z, 0x05040100u), pp, a4); a5 = dot2bf(__builtin_amdgcn_perm(y.z, x.z, 0x07060302u), pp, a5);
      a6 = dot2bf(__builtin_amdgcn_perm(y.w, x.w, 0x05040100u), pp, a6); a7 = dot2bf(__builtin_amdgcn_perm(y.w, x.w, 0x07060302u), pp, a7);
    }
#pragma unroll
    for (int o = 8; o < 64; o <<= 1) {
      a0 += __shfl_xor(a0, o, 64); a1 += __shfl_xor(a1, o, 64); a2 += __shfl_xor(a2, o, 64); a3 += __shfl_xor(a3, o, 64);
      a4 += __shfl_xor(a4, o, 64); a5 += __shfl_xor(a5, o, 64); a6 += __shfl_xor(a6, o, 64); a7 += __shfl_xor(a7, o, 64);
    }
    if (kg == 0) {
      uint4 o; o.x = pack2(a0, a1); o.y = pack2(a2, a3); o.z = pack2(a4, a5); o.w = pack2(a6, a7);
      *(uint4*)(Ob + (tokbase + qpos) * DM + hd * 64 + l7 * 8) = o;
    }
  }
}

DI void cross_item(const Params& P0_, int b, int item, uchar* smem) {
  const KP P = kparams();
  const u16* Q = (const u16*)(P.ws() + OFF_H);
  const u16* KV = (const u16*)(P.ws() + OFF_KV);
  u16* Ob = (u16*)(P.ws() + OFF_O);
  const int tid = otid(), lane = tid & 63, wave = tid >> 6, h = lane >> 5, r31 = lane & 31;
  const int hd = (item >> 5) & 3, qb = item & 31;
  const int qpos = qb * 128 + wave * 32 + r31;
  const size_t tok = (size_t)b * SL + qpos;
  uchar* Ks = smem; uchar* Vs = smem + 33792;
  f32x16 O[8];
#pragma unroll
  for (int i = 0; i < 8; ++i) O[i] = zero16();
  float m = -1e30f, ls = 0.f;
  const u16* qrow = Q + ((size_t)(hd * (NT / 32) + ((size_t)b * SL + qb * 128 + wave * 32) / 32) * 16 * 64 + lane) * 8;
  const int blk = (lane >> 4) & 1, q4 = (lane & 15) >> 2, p4 = lane & 3;
  for (int t = 0; t < 4; ++t) {
    __syncthreads();
    for (int i = 0; i < 8; ++i) {
      int c = tid + 256 * i, row = c >> 5, kc = c & 31;
      const u16* src = KV + ((size_t)b * 256 + t * 64 + row) * 2048 + hd * 256 + kc * 8;
      *(uint4*)(Ks + row * 528 + kc * 16) = *(const uint4*)src;
      *(uint4*)(Vs + row * 528 + kc * 16) = *(const uint4*)(src + 1024);
    }
    __syncthreads();
    f32x16 st[2]; st[0] = zero16(); st[1] = zero16();
#pragma unroll 4
    for (int s = 0; s < 16; ++s) {
      bf16x8 qf = *(const bf16x8*)(qrow + s * 512);
#pragma unroll
      for (int kt = 0; kt < 2; ++kt) {
        bf16x8 kf = *(const bf16x8*)(Ks + (32 * kt + r31) * 528 + (2 * s + h) * 16);
        st[kt] = mfma32(kf, qf, st[kt]);
      }
    }
    bf16x8 pf[4];
    softmax_far<8>(st, 0.0625f * LOG2E, 0.f, m, ls, O, pf);
#pragma unroll
    for (int sp = 0; sp < 4; ++sp) {
#pragma unroll
      for (int dt = 0; dt < 8; ++dt) {
        const uchar* a = Vs + (16 * sp + 4 * h + q4) * 528 + 64 * dt + 32 * blk + 8 * p4;
        s16x4 lo = tr_read(a), hi = tr_read(a + 8 * 528);
        bf16x8 vf = __builtin_shufflevector(lo, hi, 0, 1, 2, 3, 4, 5, 6, 7);
        O[dt] = mfma32(vf, pf[sp], O[dt]);
      }
    }
  }
  ls += __shfl_xor(ls, 32, 64);
  const float inv = 1.f / ls;
  __syncthreads();
#pragma unroll
  for (int dt = 0; dt < 8; ++dt)
#pragma unroll
    for (int g = 0; g < 4; ++g) {
      uint2 o; o.x = pack2(O[dt][4 * g] * inv, O[dt][4 * g + 1] * inv); o.y = pack2(O[dt][4 * g + 2] * inv, O[dt][4 * g + 3] * inv);
      *(uint2*)(smem + (wave * 32 + r31) * 528 + (32 * dt + 8 * g + 4 * h) * 2) = o;
    }
  __syncthreads();
#pragma unroll 4
  for (int i = 0; i < 16; ++i) {
    const int id = tid + 256 * i, row = (id >> 2) & 127, c = ((id >> 9) << 2) | (id & 3);
    const uint4 v = *(const uint4*)(smem + row * 528 + c * 16);
    *(uint4*)(Ob + kblk(NT, (size_t)b * SL + qb * 128 + row, hd * 256 + c * 8)) = v;
  }
}


#ifdef NO_CMP
#define CALL_CMP(x)
#else
#define CALL_CMP(x) x
#endif
#ifdef NO_DSA
#define CALL_DSA(x)
#else
#define CALL_DSA(x) x
#endif
#ifdef NO_DIFF
#define CALL_DIFF(x)
#else
#define CALL_DIFF(x) x
#endif
#ifdef NO_MOBA
#define CALL_MOBA(x)
#else
#define CALL_MOBA(x) x
#endif
#ifdef NO_NSA
#define CALL_NSA(x)
#else
#define CALL_NSA(x) x
#endif
#ifdef NO_CROSS
#define CALL_CROSS(x)
#else
#define CALL_CROSS(x) x
#endif

#define XB_TMO      128
#define XB_XCNT(j)  (256  + 64 * (j))
#define XB_XSUB(j)  (1280 + 64 * (j))
#define XB_XGEN(j)  (2304 + 64 * (j))
#define XB_TOP      3328
#define XB_TOPGEN   3392
#define XB_SPIN_CAP (1u << 22)
#define LAS __attribute__((address_space(3)))
DI unsigned xb_ld(unsigned* p)              { return __hip_atomic_load(p, __ATOMIC_RELAXED, __HIP_MEMORY_SCOPE_AGENT); }
DI unsigned xb_add(unsigned* p, unsigned v) { return __hip_atomic_fetch_add(p, v, __ATOMIC_RELAXED, __HIP_MEMORY_SCOPE_AGENT); }
DI unsigned xb_xcc_id() { return (unsigned)__builtin_amdgcn_s_getreg((3 << 11) | 20) & 0xFu; }
#define XB_SPIN(cond, bar) do { unsigned _sp = 0; while (cond) { __builtin_amdgcn_s_sleep(1); \
    if ((++_sp & 255u) == 0u) { if (xb_ld(&(bar)[XB_TMO])) break; if (_sp > XB_SPIN_CAP) { atomicAdd(&(bar)[XB_TMO], 1u); break; } } } } while (0)
struct XcdBarrier { unsigned* bar; unsigned x; volatile LAS unsigned* st; };
DI XcdBarrier xcd_barrier_post(unsigned* bar, volatile LAS unsigned* st) {
  XcdBarrier b; b.bar = bar; b.x = xb_xcc_id(); b.st = st;
  if (threadIdx.x == 0) (void)xb_add(&bar[XB_XCNT(b.x)], 1u);
  return b;
}
DI void xcd_barrier_complete(unsigned* bar, unsigned x, unsigned& nloc, unsigned& nx) {
  const unsigned G = gridDim.x * gridDim.y * gridDim.z;
  unsigned sum, cnt, mine, sp = 0u;
  for (;;) {
    sum = 0u; cnt = 0u; mine = 0u;
#pragma unroll
    for (unsigned j = 0; j < 16; ++j) { const unsigned c = xb_ld(&bar[XB_XCNT(j)]); sum += c; cnt += (c > 0u) ? 1u : 0u; mine = (j == x) ? c : mine; }
    if (sum == G) break;
    __builtin_amdgcn_s_sleep(1);
    if ((++sp & 255u) == 0u) { if (xb_ld(&bar[XB_TMO])) break; if (sp > XB_SPIN_CAP) { atomicAdd(&bar[XB_TMO], 1u); break; } }
  }
  nloc = mine > 0u ? mine : 1u; nx = cnt > 0u ? cnt : 1u;
}
DI void xcd_barrier(const XcdBarrier& b) {
  asm volatile("s_waitcnt vmcnt(0)" ::: "memory");
  __syncthreads();
  if (threadIdx.x == 0) {
    unsigned* bar = b.bar;
    __builtin_amdgcn_s_waitcnt(0);
    unsigned nloc = b.st[0], nx = b.st[1];
    if (nloc == 0u) { xcd_barrier_complete(bar, b.x, nloc, nx); b.st[0] = nloc; b.st[1] = nx; }
    const unsigned old = xb_add(&bar[XB_XSUB(b.x)], 1u);
    const unsigned gen = old / nloc;
    if (old + 1u == (gen + 1u) * nloc) {
      __builtin_amdgcn_fence(__ATOMIC_RELEASE, "agent");
      asm volatile("s_waitcnt vmcnt(0)" ::: "memory");
      const unsigned og = xb_add(&bar[XB_TOP], 1u);
      const unsigned tg = og / nx;
      if (og + 1u == (tg + 1u) * nx) xb_add(&bar[XB_TOPGEN], 1u);
      else XB_SPIN(xb_ld(&bar[XB_TOPGEN]) == tg, bar);
      __builtin_amdgcn_fence(__ATOMIC_ACQUIRE, "agent");
      xb_add(&bar[XB_XGEN(b.x)], 1u);
      asm volatile("s_waitcnt vmcnt(0)" ::: "memory");
    } else {
      XB_SPIN(xb_ld(&bar[XB_XGEN(b.x)]) == gen, bar);
      __builtin_amdgcn_fence(__ATOMIC_ACQUIRE, "agent");
      asm volatile("s_waitcnt vmcnt(0)" ::: "memory");
    }
  }
  __syncthreads();
}

__global__ void __launch_bounds__(NTHREADS, 2) fwd_megakernel(Params PARG) {
  __shared__ __attribute__((aligned(16))) uchar smem[LDS_BYTES];
  __shared__ int s_slot;
  cg::grid_group grid = cg::this_grid();
  __shared__ uint4 xb_words;
  if (threadIdx.x == 0) xb_words = make_uint4(0u, 0u, 0u, 0u);
  __syncthreads();
  const XcdBarrier xb = xcd_barrier_post((unsigned*)(kparams().ws() + OFF_BAR), (volatile LAS unsigned*)&xb_words);
  {
    const KP P = kparams();
    uchar* ws = P.ws();
    convert_flat(P.in(0), (u16*)(ws + OFF_XB), (size_t)NT * DM);
    convert_flat(P.in(1), (u16*)(ws + OFF_MEMB), (size_t)2048 * 1024);
    convert_layer_weights(PARG, 0, smem);
  }
  grid.sync();
  for (int l = 0; l < DEPTH; ++l) {
    const KP P = kparams();
    uchar* ws = P.ws();
    u16* Xb = (u16*)(ws + OFF_XB);
    u16* Hb = (u16*)(ws + OFF_H);
    u16* Ob = (u16*)(ws + OFF_O);
    unsigned* ctr = (unsigned*)(ws + OFF_CTR);
    float* X = P.out();
    for (int rep = 0; rep < REP_G; ++rep) {
    { LnArgs kq{nullptr, nullptr, nullptr, nullptr, (float2*)(ws + OFF_KIF), 0u};
      gemm_phase<EPI_BF16>(Xb, NT, (const u16*)(ws + W_IN), HC, NT, HC, DM, Hb, HC, nullptr, smem, 0, kq); }
    xcd_barrier(xb);
    }
    for (int rep = 0; rep < REP_P2; ++rep) {
      unsigned* c = ctr + l * 64 + 0 + rep * 32;
      const int n_cmp = 2 * 8 * 51, n_km = 128, n_kv = 128;
      for (;;) {
        int it = next_item(c, &s_slot);
        if (it >= n_cmp + n_km + n_kv) break;
        if (it < n_cmp) { CALL_CMP(compress_item(PARG, l, it, smem)); }
        else if (it < n_cmp + n_km) { kmean_item(PARG, it - n_cmp, smem); }
        else {
          const int t = it - n_cmp - n_km;
          __syncthreads();
          gemm_tile256<EPI_BF16>((const u16*)(ws + OFF_MEMB), 2048, (const u16*)(ws + W_XK), 2048, DM, (t >> 4) * 256, (t & 15) * 128, (u16*)(ws + OFF_KV), 2048, nullptr, smem);
        }
      }
      int att = 0, b = 0;
      for (;;) {
        int it = next_item_b(ctr + l * 64 + 8 + rep * 32, 1024, att, b, &s_slot);
        if (it < 0) break;
        CALL_DSA(dsa_item(PARG, b, it, smem));
      }
    }
    xcd_barrier(xb);
    for (int rep = 0; rep < REP_P3; ++rep) {
      int att = 0, b = 0;
      for (;;) {
        int it = next_item_b(ctr + l * 64 + 16 + rep * 32, 512, att, b, &s_slot);
        if (it < 0) break;
        if (it < 128) { CALL_DIFF(diff_item(PARG, l, b, it, smem)); }
        else if (it < 256) { CALL_DSA(dsa_dense_item(PARG, b, it - 128, smem)); }
        else if (it < 384) { CALL_MOBA(moba_item(PARG, b, it - 256, smem)); }
        else { CALL_NSA(nsa_item(PARG, b, it - 384, smem)); }
      }
    }
    xcd_barrier(xb);
    { LnArgs ln{P.in(16) + l * DM, P.in(17) + l * DM, nullptr, ctr + 256, (float2*)(ws + OFF_STATS), 8u * (unsigned)(l * 3 + 1)};
      gemm_phase<EPI_RESID>(Ob, NT, (const u16*)(ws + W_OUT), DM, NT, DM, DM, nullptr, DM, Xb, smem, 0, ln); }
    xcd_barrier(xb);
    gemm_phase<EPI_QF>(Xb, NT, (const u16*)(ws + W_XQ), DM, NT, DM, DM, Hb, DM, nullptr, smem, 0);
    xcd_barrier(xb);
    for (int rep = 0; rep < REP_X; ++rep) {
      int att = 0, b = 0;
      for (;;) {
        int it = next_item_b(ctr + l * 64 + 24 + rep * 32, 128, att, b, &s_slot);
        if (it < 0) break;
        CALL_CROSS(cross_item(PARG, b, it, smem));
      }
    }
    xcd_barrier(xb);
    { LnArgs ln{P.in(22) + l * DM, P.in(23) + l * DM, nullptr, ctr + 256, (float2*)(ws + OFF_STATS), 8u * (unsigned)(l * 3 + 2)};
      gemm_phase<EPI_RESID>(Ob, NT, (const u16*)(ws + W_XO), DM, NT, DM, DM, nullptr, DM, Xb, smem, 0, ln); }
    xcd_barrier(xb);
    for (int rep = 0; rep < REP_G; ++rep) {
    gemm_phase<EPI_RELU2>(Xb, NT, (const u16*)(ws + W_1), DFF, NT, DFF, DM, Hb, DFF, nullptr, smem, 0);
    xcd_barrier(xb);
    }
    { LnArgs ln{P.in(26) + l * DM, P.in(27) + l * DM, (l == DEPTH - 1) ? P.out() : nullptr, ctr + 256, (float2*)(ws + OFF_STATS), 8u * (unsigned)(l * 3 + 3)};
      gemm_phase<EPI_RESID>(Hb, NT, (const u16*)(ws + W_2), DM, NT, DM, DFF, nullptr, DM, Xb, smem, 0, ln); }
    xcd_barrier(xb);
    if (l + 1 < DEPTH) { convert_layer_weights(PARG, l + 1, smem); xcd_barrier(xb); }
  }
}

extern "C" void kernel_launch(void* const* d_in, const int* in_sizes, int n_in, void* d_out, int out_size, void* d_ws, size_t ws_size,
                              hipStream_t stream) {
  static int grid_blocks = 0;
  if (!grid_blocks) {
    int dev = 0, cus = 0, per_cu = 0;
    hipGetDevice(&dev);
    hipDeviceGetAttribute(&cus, hipDeviceAttributeMultiprocessorCount, dev);
    hipOccupancyMaxActiveBlocksPerMultiprocessor(&per_cu, fwd_megakernel, NTHREADS, 0);
    if (per_cu < 1) per_cu = 1;
    if (per_cu > 2) per_cu = 2;
    grid_blocks = cus * per_cu;
    if (ws_size < WS_END) fprintf(stderr, "workspace too small: %zu < %zu\n", ws_size, (size_t)WS_END);
  }
  Params p{};
  for (int i = 0; i < 28; ++i) p.in[i] = (const float*)d_in[i];
  p.out = (float*)d_out;
  p.ws = (uchar*)d_ws;
  hipMemsetAsync((uchar*)d_ws + OFF_CTR, 0, CTR_BYTES + BAR_BYTES, stream);
  void* args[] = {&p};
  hipError_t e = hipLaunchCooperativeKernel((void*)fwd_megakernel, dim3(grid_blocks), dim3(NTHREADS), args, 0, stream);
  if (e != hipSuccess) fprintf(stderr, "cooperative launch failed: %s (grid %d)\n", hipGetErrorString(e), grid_blocks);
}
```

```cpp
#include <hip/hip_runtime.h>
#include <hip/hip_cooperative_groups.h>
#include <cstdio>
namespace cg = cooperative_groups;

typedef unsigned short u16;
typedef unsigned char uchar;
typedef short bf16x8 __attribute__((ext_vector_type(8)));
typedef short s16x4 __attribute__((ext_vector_type(4)));
typedef float f32x16 __attribute__((ext_vector_type(16)));

#define DI __device__ __forceinline__

constexpr int NB = 8, SL = 4096, DM = 1024, DEPTH = 4, NT = NB * SL;
constexpr int HC = 3584;
constexpr int IN_COLS = 3540;
constexpr int DFF = 4096;
constexpr int A_Q = 0, A_K = 256, A_V = 512, A_QI = 768, A_KI = 1280;
constexpr int B_Q = 1344, B_KC = 1600, B_VC = 1664, B_KS = 1728, B_VS = 1792, B_KW = 1856, B_VW = 1920;
constexpr int C_Q = 1984, C_K = 2240, C_V = 2496, D_Q = 2752, D_K = 3008, D_V = 3264, A_W = 3520, B_G = 3528;
constexpr float ALPHA = 1.681792830507429f;
constexpr int LDS_BYTES = 75776;
constexpr int NTHREADS = 256;
#define REP_G 1
#define REP_P2 1
#define REP_P3 1
#define REP_X 1

constexpr size_t W_IN = 0;
constexpr size_t W_OUT = W_IN + (size_t)HC * 1024 * 2;
constexpr size_t W_XQ = W_OUT + 2097152;
constexpr size_t W_XK = W_XQ + 2097152;
constexpr size_t W_XV = W_XK + 2097152;
constexpr size_t W_XO = W_XV + 2097152;
constexpr size_t W_1 = W_XO + 2097152;
constexpr size_t W_2 = W_1 + 8388608;
constexpr size_t W_END = W_2 + 8388608;
constexpr size_t OFF_XB = W_END;
constexpr size_t OFF_H = OFF_XB + (size_t)NT * 1024 * 2;
constexpr size_t OFF_O = OFF_H + (size_t)NT * 4096 * 2;
constexpr size_t OFF_MEMB = OFF_O + (size_t)NT * 1024 * 2;
constexpr size_t OFF_KV = OFF_MEMB + 2048 * 1024 * 2;
constexpr size_t OFF_KC = OFF_KV + 2048 * 2048 * 2;
constexpr size_t OFF_VC = OFF_KC + 8 * 256 * 64 * 2;
constexpr size_t OFF_KM = OFF_VC + 8 * 256 * 64 * 2;
constexpr size_t OFF_SEL = OFF_KM + 8 * 16 * 256 * 4;
constexpr size_t OFF_CTR = OFF_SEL + (size_t)NT * 256 * 2;
constexpr size_t CTR_BYTES = 2048;
constexpr size_t OFF_BAR = OFF_CTR + CTR_BYTES;
constexpr size_t BAR_BYTES = 3456 * 4;
constexpr size_t OFF_STATS = OFF_BAR + BAR_BYTES;
constexpr size_t OFF_KIF = OFF_STATS + (size_t)128 * 8 * 256 * 8;
constexpr size_t OFF_WALT = OFF_KIF + (size_t)NT * 64 * 2;
constexpr size_t WS_END = OFF_WALT + W_END;

struct Params {
  const float* in[28];
  float* out;
  uchar* ws;
};

typedef const Params __attribute__((address_space(4))) CParams;
struct KP {
  CParams* p;
  DI const float* in(int i) const { return p->in[i]; }
  DI float* out() const { return p->out; }
  DI uchar* ws() const { return p->ws; }
};
DI KP kparams() {
  KP k;
#if defined(__HIP_DEVICE_COMPILE__)
  k.p = (CParams*)__builtin_amdgcn_kernarg_segment_ptr();
  asm volatile("" : "+s"(k.p));
#else
  k.p = nullptr;
#endif
  return k;
}
__device__ const uchar BUCKET_LUT[132] = {0, 1, 2, 3, 4, 5, 6, 7, 8, 9, 10, 11, 12, 13, 14, 15, 16, 16, 16, 17, 17, 18, 18, 18, 19, 19, 19, 20, 20, 20, 20, 21, 21, 21, 21, 22, 22, 22, 22, 22, 23, 23, 23, 23, 23, 23, 24, 24, 24, 24, 24, 24, 25, 25, 25, 25, 25, 25, 25, 26, 26, 26, 26, 26, 26, 26, 26, 27, 27, 27, 27, 27, 27, 27, 27, 27, 27, 28, 28, 28, 28, 28, 28, 28, 28, 28, 28, 29, 29, 29, 29, 29, 29, 29, 29, 29, 29, 29, 29, 30, 30, 30, 30, 30, 30, 30, 30, 30, 30, 30, 30, 30, 30, 31, 31, 31, 31, 31, 31, 31, 31, 31, 31, 31, 31, 31, 31, 31, 31, 31, 31, 31};

DI int otid() { int t = threadIdx.x; asm volatile("" : "+v"(t)); return t; }
DI u16 f2bf(float x) { unsigned u = __float_as_uint(x); u += 0x7fffu + ((u >> 16) & 1u); return (u16)(u >> 16); }
typedef __bf16 bf16x2_t __attribute__((ext_vector_type(2)));
typedef float f32x2_t __attribute__((ext_vector_type(2)));
DI unsigned pack2(float a, float b) { f32x2_t x = {a, b}; return __builtin_bit_cast(unsigned, __builtin_convertvector(x, bf16x2_t)); }
DI float bf2f(u16 v) { return __uint_as_float(((unsigned)v) << 16); }
DI float bflo(unsigned v) { return __uint_as_float(v << 16); }
DI float bfhi(unsigned v) { return __uint_as_float(v & 0xffff0000u); }
DI f32x16 mfma32(bf16x8 a, bf16x8 b, f32x16 c) { return __builtin_amdgcn_mfma_f32_32x32x16_bf16(a, b, c, 0, 0, 0); }
DI f32x16 zero16() { f32x16 z; for (int i = 0; i < 16; ++i) z[i] = 0.f; return z; }
DI f32x16 zero16v() { float zz = 0.f; asm volatile("" : "+v"(zz)); f32x16 z; for (int i = 0; i < 16; ++i) z[i] = zz; return z; }
DI s16x4 tr_read(const uchar* p) {
  return __builtin_amdgcn_ds_read_tr16_b64_v4i16((s16x4 __attribute__((address_space(3)))*)(p));
}
DI bf16x8 pack8(const f32x16& x, int s) {
  uint4 p;
  p.x = pack2(x[8 * s + 0], x[8 * s + 1]); p.y = pack2(x[8 * s + 2], x[8 * s + 3]);
  p.z = pack2(x[8 * s + 4], x[8 * s + 5]); p.w = pack2(x[8 * s + 6], x[8 * s + 7]);
  return __builtin_bit_cast(bf16x8, p);
}
DI float wave_sum(float v) { for (int o = 32; o > 0; o >>= 1) v += __shfl_xor(v, o, 64); return v; }
DI float wave_max(float v) { for (int o = 32; o > 0; o >>= 1) v = fmaxf(v, __shfl_xor(v, o, 64)); return v; }

typedef __bf16 bf2_t __attribute__((ext_vector_type(2)));
typedef float f32x2 __attribute__((ext_vector_type(2)));
DI float dot2bf(unsigned a, unsigned b, float c) { return __builtin_amdgcn_fdot2_f32_bf16(__builtin_bit_cast(bf2_t, a), __builtin_bit_cast(bf2_t, b), c, false); }
DI float red8(float v) {
  v += __builtin_amdgcn_update_dpp(0.f, v, 0xB1, 0xf, 0xf, true);
  v += __builtin_amdgcn_update_dpp(0.f, v, 0x4E, 0xf, 0xf, true);
  v += __builtin_amdgcn_update_dpp(0.f, v, 0x141, 0xf, 0xf, true);
  return v;
}
DI int wave_sum_i(int v) {
  v += __builtin_amdgcn_update_dpp(0, v, 0xB1, 0xf, 0xf, true);
  v += __builtin_amdgcn_update_dpp(0, v, 0x4E, 0xf, 0xf, true);
  v += __builtin_amdgcn_update_dpp(0, v, 0x141, 0xf, 0xf, true);
  v += __builtin_amdgcn_update_dpp(0, v, 0x140, 0xf, 0xf, true);
  return __builtin_amdgcn_readlane(v, 0) + __builtin_amdgcn_readlane(v, 16) + __builtin_amdgcn_readlane(v, 32) + __builtin_amdgcn_readlane(v, 48);
}

DI int next_item(unsigned* ctr, int* s_slot) {
  __syncthreads();
  if (threadIdx.x == 0) *s_slot = (int)atomicAdd(ctr, 1u);
  __syncthreads();
  return *s_slot;
}


DI int next_item_b(unsigned* q8, int per_batch, int& att, int& b, int* s_slot) {
  for (;;) {
    if (att >= 8) return -1;
    b = (int)((blockIdx.x + att) & 7);
    int it = next_item(q8 + b, s_slot);
    if (it < per_batch) return it;
    ++att;
  }
}

DI void stage64(uchar* dst, const u16* src, size_t row_stride) {
  const int tid = otid();
#pragma unroll
  for (int i = 0; i < 2; ++i) {
    int c = tid + 256 * i, row = c >> 3, kc = c & 7;
    uint4 v = *(const uint4*)(src + (size_t)row * row_stride + kc * 8);
    *(uint4*)(dst + row * 144 + kc * 16) = v;
  }
}

DI void qk_tile(f32x16 st[2], const bf16x8* qf, int s0, int ns, const uchar* Ks, int r31, int h) {
#pragma unroll
  for (int kt = 0; kt < 2; ++kt) {
    st[kt] = zero16();
#pragma unroll
    for (int s = 0; s < ns; ++s) {
      bf16x8 kf = *(const bf16x8*)(Ks + (32 * kt + r31) * 144 + (2 * (s0 + s) + h) * 16);
      st[kt] = mfma32(kf, qf[s0 + s], st[kt]);
    }
  }
}

DI void pv_tile(f32x16 O[2], const bf16x8 pf[4], const uchar* Vs, int lane) {
  const int h = lane >> 5, blk = (lane >> 4) & 1, q4 = (lane & 15) >> 2, p = lane & 3;
#pragma unroll
  for (int sp = 0; sp < 4; ++sp) {
#pragma unroll
    for (int dt = 0; dt < 2; ++dt) {
      const uchar* a = Vs + (16 * sp + 4 * h + q4) * 144 + 64 * dt + 32 * blk + 8 * p;
      s16x4 lo = tr_read(a), hi = tr_read(a + 8 * 144);
      bf16x8 vf = __builtin_shufflevector(lo, hi, 0, 1, 2, 3, 4, 5, 6, 7);
      O[dt] = mfma32(vf, pf[sp], O[dt]);
    }
  }
}

constexpr float LOG2E = 1.4426950408889634f;
template <int NO, bool COND>
DI void sm_rescale(float& m, float mx, float& lsum, f32x16* O) {
  if (!COND || __builtin_amdgcn_ballot_w64(mx > m) != 0ull) {
    const float corr = __builtin_amdgcn_exp2f(m - mx);
    lsum *= corr;
#pragma unroll
    for (int o = 0; o < NO; ++o)
#pragma unroll
      for (int i = 0; i < 16; ++i) O[o][i] *= corr;
  }
  m = mx;
}
DI float max16(const f32x16& x) {
  float a = fmaxf(fmaxf(x[0], x[1]), x[2]), b = fmaxf(fmaxf(x[3], x[4]), x[5]), c = fmaxf(fmaxf(x[6], x[7]), x[8]);
  float d = fmaxf(fmaxf(x[9], x[10]), x[11]), e = fmaxf(fmaxf(x[12], x[13]), x[14]);
  return fmaxf(fmaxf(fmaxf(a, b), fmaxf(c, d)), fmaxf(e, x[15]));
}
template <int NO, bool COND = true>
DI void softmax_step(f32x16 st[2], float& m, float& lsum, f32x16* O, bf16x8 pf[4]) {
  float mx = fmaxf(m, fmaxf(max16(st[0]), max16(st[1])));
  mx = fmaxf(mx, __shfl_xor(mx, 32, 64));
  sm_rescale<NO, COND>(m, mx, lsum, O);
#pragma unroll
  for (int kt = 0; kt < 2; ++kt)
#pragma unroll
    for (int i = 0; i < 16; ++i) { float p = __builtin_amdgcn_exp2f(st[kt][i] - mx); lsum += p; st[kt][i] = p; }
#pragma unroll
  for (int kt = 0; kt < 2; ++kt) { pf[2 * kt] = pack8(st[kt], 0); pf[2 * kt + 1] = pack8(st[kt], 1); }
}
template <int NO, bool COND = true>
DI void softmax_far(f32x16 st[2], float c2, float b2, float& m, float& lsum, f32x16* O, bf16x8 pf[4]) {
  float mr = fmaxf(max16(st[0]), max16(st[1]));
  float mx = fmaxf(m, mr * c2 + b2);
  mx = fmaxf(mx, __shfl_xor(mx, 32, 64));
  sm_rescale<NO, COND>(m, mx, lsum, O);
  const float off = b2 - mx;
#pragma unroll
  for (int kt = 0; kt < 2; ++kt)
#pragma unroll
    for (int i = 0; i < 16; ++i) { float p = __builtin_amdgcn_exp2f(__builtin_fmaf(st[kt][i], c2, off)); lsum += p; st[kt][i] = p; }
#pragma unroll
  for (int kt = 0; kt < 2; ++kt) { pf[2 * kt] = pack8(st[kt], 0); pf[2 * kt + 1] = pack8(st[kt], 1); }
}

DI int crow(int i, int h) { return (i & 3) + 8 * (i >> 2) + 4 * h; }

DI int colmap_in(int n) {
  if (n < 1344) return n;
  if (n < 1984) return n + 8;
  if (n < 3520) return n + 20;
  if (n < 3528) return 1344 + (n - 3520);
  if (n < 3540) return 1992 + (n - 3528);
  return -1;
}
DI void transpose_convert(const float* __restrict__ src, int K, int Nsrc, u16* __restrict__ dst, int Ndst, bool remap, uchar* smem, int Ntot = 0, int nofs = 0) {
  if (Ntot == 0) Ntot = Ndst;
  float* tile = (float*)smem;
  const int tid = otid();
  const int nkt = K / 64, ntiles = (Ndst / 64) * nkt;
  for (int t = blockIdx.x; t < ntiles; t += gridDim.x) {
    const int kt = t % nkt, nt = t / nkt;
    __syncthreads();
#pragma unroll 4
    for (int i = 0; i < 16; ++i) {
      int e = tid + 256 * i, r = e >> 6, c = e & 63;
      int n = nt * 64 + c;
      int sc = remap ? colmap_in(n) : n;
      float v = sc >= 0 ? src[(size_t)(kt * 64 + r) * Nsrc + sc] : 0.f;
      tile[r * 65 + c] = v;
    }
    __syncthreads();
#pragma unroll
    for (int i = 0; i < 2; ++i) {
      int e = tid + 256 * i, n = e >> 3, kc = e & 7;
      uint4 o;
      o.x = pack2(tile[(kc * 8 + 0) * 65 + n], tile[(kc * 8 + 1) * 65 + n]);
      o.y = pack2(tile[(kc * 8 + 2) * 65 + n], tile[(kc * 8 + 3) * 65 + n]);
      o.z = pack2(tile[(kc * 8 + 4) * 65 + n], tile[(kc * 8 + 5) * 65 + n]);
      o.w = pack2(tile[(kc * 8 + 6) * 65 + n], tile[(kc * 8 + 7) * 65 + n]);
      *(uint4*)(dst + ((size_t)(kt * 2 + (kc >> 2)) * Ntot + nofs + nt * 64 + n) * 32 + (kc & 3) * 8) = o;
    }
  }
}

DI void convert_layer_weights(const Params& P0_, int l, uchar* smem) {
  const KP P = kparams();
  uchar* ws = P.ws() + ((l & 1) ? OFF_WALT : 0);
  transpose_convert(P.in(3) + (size_t)l * 1024 * IN_COLS, 1024, IN_COLS, (u16*)(ws + W_IN), HC, true, smem);
  transpose_convert(P.in(4) + (size_t)l * 1024 * 1024, 1024, 1024, (u16*)(ws + W_OUT), 1024, false, smem);
  transpose_convert(P.in(18) + (size_t)l * 1024 * 1024, 1024, 1024, (u16*)(ws + W_XQ), 1024, false, smem);
  transpose_convert(P.in(19) + (size_t)l * 1024 * 1024, 1024, 1024, (u16*)(ws + W_XK), 1024, false, smem, 2048, 0);
  transpose_convert(P.in(20) + (size_t)l * 1024 * 1024, 1024, 1024, (u16*)(ws + W_XK), 1024, false, smem, 2048, 1024);
  transpose_convert(P.in(21) + (size_t)l * 1024 * 1024, 1024, 1024, (u16*)(ws + W_XO), 1024, false, smem);
  transpose_convert(P.in(24) + (size_t)l * 1024 * DFF, 1024, DFF, (u16*)(ws + W_1), DFF, false, smem);
  transpose_convert(P.in(25) + (size_t)l * DFF * 1024, DFF, 1024, (u16*)(ws + W_2), 1024, false, smem);
}

DI size_t kblk(size_t M, size_t m, int k) { return ((size_t)(k >> 5) * M + m) * 32 + (k & 31); }
DI void convert_flat(const float* __restrict__ src, u16* __restrict__ dst, size_t n) {
  size_t nv = n / 8;
  for (size_t i = (size_t)blockIdx.x * NTHREADS + threadIdx.x; i < nv; i += (size_t)gridDim.x * NTHREADS) {
    float4 a = *(const float4*)(src + i * 8), b = *(const float4*)(src + i * 8 + 4);
    uint4 o; o.x = pack2(a.x, a.y); o.y = pack2(a.z, a.w); o.z = pack2(b.x, b.y); o.w = pack2(b.z, b.w);
    const size_t e = i * 8, m = e >> 10; const int k = (int)(e & 1023);
    *(uint4*)(dst + kblk(n >> 10, m, k)) = o;
  }
}

enum { EPI_BF16 = 0, EPI_RELU2 = 1, EPI_RESID = 2, EPI_QF = 3 };
struct LnArgs { const float* g; const float* b; float* fout; unsigned* flags; float2* stats; unsigned target; };
template <int EPI>
DI void gemm_tile256(const u16* __restrict__ A, int lda, const u16* __restrict__ Bt, int ldb, int K, int m0, int n0,
                     void* Cout, int ldc, const u16* Xres, uchar* smem, LnArgs ln = LnArgs{}) {
  const int tid = otid(), lane = tid & 63, wave = tid >> 6, wr = wave >> 1, wc = wave & 1, h = lane >> 5, r31 = lane & 31;
  f32x16 acc[4][2];
#pragma unroll
  for (int a = 0; a < 4; ++a)
#pragma unroll
    for (int b = 0; b < 2; ++b) acc[a][b] = zero16();
  const int nk = K / 32;
  constexpr int SB = 24576, BO = 16384;
  const int gc = (tid & 3) ^ ((tid >> 4) & 3);
  const u16* Ap = A + (size_t)(m0 + (tid >> 2)) * 32 + gc * 8;
  const u16* Bp = Bt + (size_t)(n0 + (tid >> 2)) * 32 + gc * 8;
#define STAGE(buf, ko) do { uchar* d_ = smem + (buf) * SB + tid * 16; \
    __builtin_amdgcn_global_load_lds((const unsigned*)(Ap + (size_t)(ko) * lda), (__attribute__((address_space(3))) unsigned*)(d_), 16, 0, 0); \
    __builtin_amdgcn_global_load_lds((const unsigned*)(Ap + (size_t)(ko) * lda + 64 * 32), (__attribute__((address_space(3))) unsigned*)(d_ + 4096), 16, 0, 0); \
    __builtin_amdgcn_global_load_lds((const unsigned*)(Ap + (size_t)(ko) * lda + 128 * 32), (__attribute__((address_space(3))) unsigned*)(d_ + 8192), 16, 0, 0); \
    __builtin_amdgcn_global_load_lds((const unsigned*)(Ap + (size_t)(ko) * lda + 192 * 32), (__attribute__((address_space(3))) unsigned*)(d_ + 12288), 16, 0, 0); \
    __builtin_amdgcn_global_load_lds((const unsigned*)(Bp + (size_t)(ko) * ldb), (__attribute__((address_space(3))) unsigned*)(d_ + 16384), 16, 0, 0); \
    __builtin_amdgcn_global_load_lds((const unsigned*)(Bp + (size_t)(ko) * ldb + 64 * 32), (__attribute__((address_space(3))) unsigned*)(d_ + 20480), 16, 0, 0); } while (0)
  const int fsw = (r31 >> 2) & 3;
  const int c0o = ((h) ^ fsw) * 16, c1o = ((2 + h) ^ fsw) * 16;
  const unsigned lds0 = (unsigned)(size_t)smem;
  const unsigned aoff = lds0 + (wr * 128 + r31) * 64, boff = lds0 + BO + (wc * 64 + r31) * 64;
#define COMPUTE(sbyte) do { \
      bf16x8 p0, p1, q0, q1, q2, q3, t0, t1, u0, u1, u2, u3; \
      const unsigned b0_ = boff + (sbyte) + c0o, a0_ = aoff + (sbyte) + c0o, b1_ = boff + (sbyte) + c1o, a1_ = aoff + (sbyte) + c1o; \
      asm volatile("ds_read_b128 %0, %12\n\tds_read_b128 %1, %12 offset:2048\n\t" \
                   "ds_read_b128 %2, %13\n\tds_read_b128 %3, %13 offset:2048\n\tds_read_b128 %4, %13 offset:4096\n\tds_read_b128 %5, %13 offset:6144\n\t" \
                   "ds_read_b128 %6, %14\n\tds_read_b128 %7, %14 offset:2048\n\t" \
                   "ds_read_b128 %8, %15\n\tds_read_b128 %9, %15 offset:2048\n\tds_read_b128 %10, %15 offset:4096\n\tds_read_b128 %11, %15 offset:6144\n\t" \
                   "s_waitcnt lgkmcnt(0)" \
                   : "=&v"(p0), "=&v"(p1), "=&v"(q0), "=&v"(q1), "=&v"(q2), "=&v"(q3), "=&v"(t0), "=&v"(t1), "=&v"(u0), "=&v"(u1), "=&v"(u2), "=&v"(u3) \
                   : "v"(b0_), "v"(a0_), "v"(b1_), "v"(a1_) : "memory"); \
      acc[0][0] = mfma32(p0, q0, acc[0][0]); acc[0][1] = mfma32(p1, q0, acc[0][1]); \
      acc[1][0] = mfma32(p0, q1, acc[1][0]); acc[1][1] = mfma32(p1, q1, acc[1][1]); \
      acc[2][0] = mfma32(p0, q2, acc[2][0]); acc[2][1] = mfma32(p1, q2, acc[2][1]); \
      acc[3][0] = mfma32(p0, q3, acc[3][0]); acc[3][1] = mfma32(p1, q3, acc[3][1]); \
      acc[0][0] = mfma32(t0, u0, acc[0][0]); acc[0][1] = mfma32(t1, u0, acc[0][1]); \
      acc[1][0] = mfma32(t0, u1, acc[1][0]); acc[1][1] = mfma32(t1, u1, acc[1][1]); \
      acc[2][0] = mfma32(t0, u2, acc[2][0]); acc[2][1] = mfma32(t1, u2, acc[2][1]); \
      acc[3][0] = mfma32(t0, u3, acc[3][0]); acc[3][1] = mfma32(t1, u3, acc[3][1]); \
      __builtin_amdgcn_sched_barrier(0); } while (0)
  __syncthreads();
  STAGE(0, 0);
  STAGE(1, 32);
  int cb = 0;
  for (int kt = 0; kt < nk; ++kt) {
    if (kt + 1 < nk) asm volatile("s_waitcnt vmcnt(6)" ::: "memory"); else asm volatile("s_waitcnt vmcnt(0)" ::: "memory");
    __builtin_amdgcn_s_barrier();
    __builtin_amdgcn_sched_barrier(0);
    if (kt + 2 < nk) { const int nb = cb >= 1 ? cb - 1 : 2; STAGE(nb, (kt + 2) * 32); }
    COMPUTE(cb * SB);
    cb = cb == 2 ? 0 : cb + 1;
  }
  __syncthreads();
#undef STAGE
#undef COMPUTE
  if (EPI == EPI_RESID) {
    const int mt = m0 >> 8, nt = n0 >> 7;
    float2* myst = ln.stats + (size_t)(mt * 8 + nt) * 256;
    float2* rowstat = (float2*)(smem + 67584);
#define STAGE_HALF(hf) do { if (wr == (hf)) { \
      _Pragma("unroll") for (int mi = 0; mi < 4; ++mi) _Pragma("unroll") for (int ni = 0; ni < 2; ++ni) _Pragma("unroll") for (int g = 0; g < 4; ++g) { \
        float4 v; v.x = acc[mi][ni][4 * g]; v.y = acc[mi][ni][4 * g + 1]; v.z = acc[mi][ni][4 * g + 2]; v.w = acc[mi][ni][4 * g + 3]; \
        *(float4*)(smem + (mi * 32 + r31) * 528 + (wc * 64 + ni * 32 + 8 * g + 4 * h) * 4) = v; } } \
      __syncthreads(); } while (0)
#pragma unroll
    for (int hf = 0; hf < 2; ++hf) {
      STAGE_HALF(hf);
#pragma unroll 4
      for (int i = 0; i < 16; ++i) {
        const int id = tid + 256 * i, row = (id >> 3) & 127, c = ((id >> 10) << 3) | (id & 7);
        float4* sp = (float4*)(smem + row * 528 + c * 16);
        const float4 v = *sp;
        const uint2 xb = *(const uint2*)(Xres + kblk(NT, (size_t)(m0 + hf * 128 + row), n0 + c * 4));
        float4 y; y.x = ALPHA * bflo(xb.x) + v.x; y.y = ALPHA * bfhi(xb.x) + v.y; y.z = ALPHA * bflo(xb.y) + v.z; y.w = ALPHA * bfhi(xb.y) + v.w;
        *sp = y;
      }
      __syncthreads();
      if (tid < 128) {
        float sa = 0.f, sq = 0.f;
#pragma unroll 8
        for (int c = 0; c < 32; ++c) {
          const float4 y = *(const float4*)(smem + tid * 528 + c * 16);
          sa += (y.x + y.y) + (y.z + y.w); sq += (y.x * y.x + y.y * y.y) + (y.z * y.z + y.w * y.w);
        }
        __hip_atomic_store((unsigned*)&myst[hf * 128 + tid].x, __float_as_uint(sa), __ATOMIC_RELAXED, __HIP_MEMORY_SCOPE_AGENT);
        __hip_atomic_store((unsigned*)&myst[hf * 128 + tid].y, __float_as_uint(sq), __ATOMIC_RELAXED, __HIP_MEMORY_SCOPE_AGENT);
      }
      __syncthreads();
    }
    asm volatile("s_waitcnt vmcnt(0)" ::: "memory");
    __syncthreads();
    if (threadIdx.x == 0) {
      (void)__hip_atomic_fetch_add(ln.flags + mt, 1u, __ATOMIC_RELAXED, __HIP_MEMORY_SCOPE_AGENT);
      unsigned sp = 0u;
      while (__hip_atomic_load(ln.flags + mt, __ATOMIC_RELAXED, __HIP_MEMORY_SCOPE_AGENT) < ln.target) { __builtin_amdgcn_s_sleep(1); if (++sp > (1u << 24)) break; }
    }
    __syncthreads();
    {
      float sa = 0.f, sq = 0.f;
#pragma unroll
      for (int k = 0; k < 8; ++k) {
        const float2* pp = ln.stats + (size_t)(mt * 8 + k) * 256 + tid;
        sa += __uint_as_float(__hip_atomic_load((const unsigned*)&pp->x, __ATOMIC_RELAXED, __HIP_MEMORY_SCOPE_AGENT));
        sq += __uint_as_float(__hip_atomic_load((const unsigned*)&pp->y, __ATOMIC_RELAXED, __HIP_MEMORY_SCOPE_AGENT));
      }
      const float mu = sa * (1.f / 1024.f);
      const float var = sq * (1.f / 1024.f) - mu * mu;
      rowstat[tid] = make_float2(mu, rsqrtf(fmaxf(var, 0.f) + 1e-5f));
    }
#pragma unroll
    for (int hf = 0; hf < 2; ++hf) {
      STAGE_HALF(hf);
#pragma unroll 4
      for (int i = 0; i < 16; ++i) {
        const int id = tid + 256 * i, row = (id >> 3) & 127, c = ((id >> 10) << 3) | (id & 7);
        const float4 v = *(const float4*)(smem + row * 528 + c * 16);
        const size_t go = kblk(NT, (size_t)(m0 + hf * 128 + row), n0 + c * 4);
        const uint2 xb = *(const uint2*)(Xres + go);
        const float2 rs = rowstat[hf * 128 + row];
        const float4 g4 = *(const float4*)(ln.g + n0 + c * 4), b4 = *(const float4*)(ln.b + n0 + c * 4);
        float4 o;
        o.x = (ALPHA * bflo(xb.x) + v.x - rs.x) * rs.y * g4.x + b4.x; o.y = (ALPHA * bfhi(xb.x) + v.y - rs.x) * rs.y * g4.y + b4.y;
        o.z = (ALPHA * bflo(xb.y) + v.z - rs.x) * rs.y * g4.z + b4.z; o.w = (ALPHA * bfhi(xb.y) + v.w - rs.x) * rs.y * g4.w + b4.w;
        uint2 ob; ob.x = pack2(o.x, o.y); ob.y = pack2(o.z, o.w);
        *(uint2*)((u16*)Xres + go) = ob;
        if (ln.fout) *(float4*)(ln.fout + (size_t)(m0 + hf * 128 + row) * ldc + n0 + c * 4) = o;
      }
      __syncthreads();
    }
#undef STAGE_HALF
  } else {
#pragma unroll
    for (int mi = 0; mi < 4; ++mi)
#pragma unroll
      for (int ni = 0; ni < 2; ++ni)
#pragma unroll
        for (int g = 0; g < 4; ++g) {
          float v0 = acc[mi][ni][4 * g], v1 = acc[mi][ni][4 * g + 1], v2 = acc[mi][ni][4 * g + 2], v3 = acc[mi][ni][4 * g + 3];
          if (EPI == EPI_RELU2) { v0 = fmaxf(v0, 0.f); v0 *= v0; v1 = fmaxf(v1, 0.f); v1 *= v1; v2 = fmaxf(v2, 0.f); v2 *= v2; v3 = fmaxf(v3, 0.f); v3 *= v3; }
          uint2 o; o.x = pack2(v0, v1); o.y = pack2(v2, v3);
          *(uint2*)(smem + (wr * 128 + mi * 32 + r31) * 272 + (wc * 64 + ni * 32 + 8 * g + 4 * h) * 2) = o;
        }
    __syncthreads();
#pragma unroll 4
    for (int i = 0; i < 16; ++i) {
      if (EPI == EPI_QF) {
        const int id = tid + 256 * i, ln64 = id & 63, ks = (id >> 6) & 7, kt8 = id >> 9;
        const uint4 v = *(const uint4*)(smem + (kt8 * 32 + (ln64 & 31)) * 272 + (2 * ks + (ln64 >> 5)) * 16);
        const size_t piece = ((size_t)((n0 >> 8) * (NT / 32) + (m0 >> 5) + kt8) * 16 + ((n0 & 255) >> 4) + ks) * 64 + ln64;
        *(uint4*)((u16*)Cout + piece * 8) = v;
      } else if (EPI == EPI_RELU2) {
        const int id = tid + 256 * i, row = (id >> 2) & 255, c = ((id >> 10) << 2) | (id & 3);
        const uint4 v = *(const uint4*)(smem + row * 272 + c * 16);
        *(uint4*)((u16*)Cout + kblk(NT, (size_t)(m0 + row), n0 + c * 8)) = v;
      } else {
      const int id = tid + 256 * i, row = id >> 4, c = id & 15;
      const uint4 v = *(const uint4*)(smem + row * 272 + c * 16);
      *(uint4*)((u16*)Cout + (size_t)(m0 + row) * ldc + n0 + c * 8) = v;
      }
    }
    if (EPI == EPI_BF16 && ldc == HC && n0 == A_KI && ln.stats) {
      u16* kif = (u16*)ln.stats;
#pragma unroll 4
      for (int i = 0; i < 8; ++i) {
        const int id = tid + 256 * i, ln64 = id & 63, ks = (id >> 6) & 3, kt8 = id >> 8;
        const uint4 v = *(const uint4*)(smem + (kt8 * 32 + (ln64 & 31)) * 272 + (2 * ks + (ln64 >> 5)) * 16);
        *(uint4*)(kif + ((size_t)(((m0 >> 5) + kt8) * 4 + ks) * 64 + ln64) * 8) = v;
      }
    }
    __syncthreads();
  }
}

template <int EPI>
DI void gemm_phase(const u16* A, int lda, const u16* Bt, int ldb, int M, int N, int K, void* C, int ldc, const u16* Xres, uchar* smem,
                           int xoff, LnArgs ln = LnArgs{}) {
  const int nN = N / 128, nM = M / 256;
  const int PC = (nN % 8 == 0) ? 8 : 4, PR = 64 / PC;
  const int npc = nN / PC, npatch = (nM / PR) * npc;
  const int x = (int)((blockIdx.x + 8 - xoff) & 7), j0 = (int)(blockIdx.x >> 3), slots = (int)(gridDim.x >> 3);
  for (int p = x; p < npatch; p += 8) {
    const int pr = p / npc, pc = p % npc;
    for (int j = j0; j < 64; j += slots) {
      const int mt = pr * PR + j / PC, nt = pc * PC + j % PC;
      gemm_tile256<EPI>(A, lda, Bt, ldb, K, mt * 256, nt * 128, C, ldc, Xres, smem, ln);
    }
  }
}

DI void ln_phase(float* __restrict__ Y, u16* __restrict__ Xb, const float* __restrict__ g, const float* __restrict__ bta, bool write_f32) {
  const int tid = otid(); const int lane = tid & 63, wave = tid >> 6;
  for (int row = blockIdx.x * 4 + wave; row < NT; row += gridDim.x * 4) {
    float* yr = Y + (size_t)row * DM;
    float4 v[4];
#pragma unroll
    for (int i = 0; i < 4; ++i) v[i] = *(const float4*)(yr + (i * 64 + lane) * 4);
    float s = 0.f;
#pragma unroll
    for (int i = 0; i < 4; ++i) s += v[i].x + v[i].y + v[i].z + v[i].w;
    s = wave_sum(s);
    const float mu = s * (1.f / DM);
    float q = 0.f;
#pragma unroll
    for (int i = 0; i < 4; ++i) { float a = v[i].x - mu, b = v[i].y - mu, c = v[i].z - mu, d = v[i].w - mu; q += a * a + b * b + c * c + d * d; }
    q = wave_sum(q);
    const float rstd = rsqrtf(q * (1.f / DM) + 1e-5f);
#pragma unroll
    for (int i = 0; i < 4; ++i) {
      const int c = (i * 64 + lane) * 4;
      float4 gg = *(const float4*)(g + c), bb = *(const float4*)(bta + c), o;
      o.x = (v[i].x - mu) * rstd * gg.x + bb.x; o.y = (v[i].y - mu) * rstd * gg.y + bb.y;
      o.z = (v[i].z - mu) * rstd * gg.z + bb.z; o.w = (v[i].w - mu) * rstd * gg.w + bb.w;
      if (write_f32) *(float4*)(yr + c) = o;
      uint2 ob; ob.x = pack2(o.x, o.y); ob.y = pack2(o.z, o.w);
      *(uint2*)(Xb + (size_t)row * DM + c) = ob;
    }
  }
}

DI void stage_bias(float* tab, const float* rel, int col) {
  for (int d = threadIdx.x; d < 132; d += NTHREADS) tab[d] = rel[BUCKET_LUT[d < 128 ? d : 128] * 16 + col] * LOG2E;
}
DI float bias_at(const float* tab, int dist) { int d = dist < 0 ? 0 : (dist > 128 ? 128 : dist); return tab[d]; }

DI void store_ot(u16* Ob, size_t tok0, int colbase, const f32x16 O[2], int lane, uchar* smem) {
  const int h = lane >> 5, r31 = lane & 31;
  uchar* stg = smem + 57344 + (otid() >> 6) * 4608;
#pragma unroll
  for (int dt = 0; dt < 2; ++dt)
#pragma unroll
    for (int g = 0; g < 4; ++g) {
      uint2 o; o.x = pack2(O[dt][4 * g], O[dt][4 * g + 1]); o.y = pack2(O[dt][4 * g + 2], O[dt][4 * g + 3]);
      *(uint2*)(stg + r31 * 144 + (32 * dt + 8 * g + 4 * h) * 2) = o;
    }
  asm volatile("s_waitcnt lgkmcnt(0)" ::: "memory");
#pragma unroll
  for (int i = 0; i < 4; ++i) {
    const int id = lane + 64 * i, row = (id >> 2) & 31, c = ((id >> 7) << 2) | (id & 3);
    const uint4 v = *(const uint4*)(stg + row * 144 + c * 16);
    *(uint4*)(Ob + kblk(NT, tok0 + row, colbase + c * 8)) = v;
  }
  asm volatile("s_waitcnt lgkmcnt(0)" ::: "memory");
}


#define KV_DECL uint4 pk0_, pk1_, pv0_, pv1_; const int kvr_ = tid >> 3, kvc_ = tid & 7
#define KV_LOAD(kp, vp, stride) do { const u16* kp_ = (kp) + (size_t)kvr_ * (stride) + kvc_ * 8; const u16* vp_ = (vp) + (size_t)kvr_ * (stride) + kvc_ * 8; \
    pk0_ = *(const uint4*)kp_; pk1_ = *(const uint4*)(kp_ + (size_t)32 * (stride)); pv0_ = *(const uint4*)vp_; pv1_ = *(const uint4*)(vp_ + (size_t)32 * (stride)); } while (0)
#define KV_STORE() do { uchar* d_ = Ks + kvr_ * 144 + kvc_ * 16; *(uint4*)d_ = pk0_; *(uint4*)(d_ + 32 * 144) = pk1_; \
    uchar* e_ = Vs + kvr_ * 144 + kvc_ * 16; *(uint4*)e_ = pv0_; *(uint4*)(e_ + 32 * 144) = pv1_; } while (0)

DI void diff_item(const Params& P0_, int l, int b, int item, uchar* smem) {
  const KP P = kparams();
  const u16* H = (const u16*)(P.ws() + OFF_H);
  u16* Ob = (u16*)(P.ws() + OFF_O);
  const int tid = otid(), lane = tid & 63, wave = tid >> 6, h = lane >> 5, r31 = lane & 31;
  const int qb = 31 - (item >> 2), hd = item & 3;
  const int q0 = qb * 128, qw0 = q0 + 32 * wave, qpos = qw0 + r31;
  uchar* Ks = smem; uchar* Vs = smem + 9216; float* tab = (float*)(smem + 18432);
  __syncthreads();
  stage_bias(tab, P.in(2), 12 + hd);
  float d1 = (lane < 32) ? P.in(11)[l * 32 + r31] * P.in(12)[l * 32 + r31] : 0.f;
  float d2 = (lane < 32) ? P.in(13)[l * 32 + r31] * P.in(14)[l * 32 + r31] : 0.f;
  d1 = wave_sum(d1); d2 = wave_sum(d2);
  const float lam_init = 0.8f - 0.6f * expf(-0.3f * (float)l);
  const float lam = expf(d1) - expf(d2) + lam_init;
  const size_t tokbase = (size_t)b * SL;
  bf16x8 qf[4];
  { const u16* qrow = H + (tokbase + qpos) * HC + D_Q + hd * 64;
#pragma unroll
    for (int s = 0; s < 4; ++s) qf[s] = *(const bf16x8*)(qrow + 16 * s + 8 * h); }
  f32x16 O0[2], O1[2];
  O0[0] = zero16(); O0[1] = zero16(); O1[0] = zero16(); O1[1] = zero16();
  float m0 = -1e30f, l0 = 0.f, m1 = -1e30f, l1 = 0.f;
  const float c2 = 0.17677669529663687f * LOG2E;
  const int nt = (q0 + 127) / 64 + 1;
  KV_DECL;
  KV_LOAD(H + tokbase * HC + D_K + hd * 64, H + tokbase * HC + D_V + hd * 64, HC);
  for (int t = 0; t < nt; ++t) {
    const int k0 = t * 64;
    __syncthreads();
    KV_STORE();
    __syncthreads();
    if (t + 1 < nt) KV_LOAD(H + (tokbase + k0 + 64) * HC + D_K + hd * 64, H + (tokbase + k0 + 64) * HC + D_V + hd * 64, HC);
    if (k0 <= qw0 + 31) {
      f32x16 st[2]; bf16x8 pf[4];
      const bool far = (qw0 - (k0 + 63)) >= 128;
      const float bfar = tab[128];
      qk_tile(st, qf, 0, 2, Ks, r31, h);
      if (far) {
        softmax_far<2>(st, c2, bfar, m0, l0, O0, pf);
      } else {
#pragma unroll
        for (int kt = 0; kt < 2; ++kt)
#pragma unroll
          for (int i = 0; i < 16; ++i) { int dist = qpos - (k0 + 32 * kt + crow(i, h)); st[kt][i] = dist >= 0 ? st[kt][i] * c2 + bias_at(tab, dist) : -INFINITY; }
        softmax_step<2>(st, m0, l0, O0, pf);
      }
      pv_tile(O0, pf, Vs, lane);
      qk_tile(st, qf, 2, 2, Ks, r31, h);
      if (far) {
        softmax_far<2>(st, c2, bfar, m1, l1, O1, pf);
      } else {
#pragma unroll
        for (int kt = 0; kt < 2; ++kt)
#pragma unroll
          for (int i = 0; i < 16; ++i) { int dist = qpos - (k0 + 32 * kt + crow(i, h)); st[kt][i] = dist >= 0 ? st[kt][i] * c2 + bias_at(tab, dist) : -INFINITY; }
        softmax_step<2>(st, m1, l1, O1, pf);
      }
      pv_tile(O1, pf, Vs, lane);
    }
  }
  l0 += __shfl_xor(l0, 32, 64); l1 += __shfl_xor(l1, 32, 64);
  const float i0 = 1.f / l0, i1 = lam / l1;
  float ss = 0.f;
#pragma unroll
  for (int dt = 0; dt < 2; ++dt)
#pragma unroll
    for (int i = 0; i < 16; ++i) { float v = O0[dt][i] * i0 - O1[dt][i] * i1; O0[dt][i] = v; ss += v * v; }
  ss += __shfl_xor(ss, 32, 64);
  const float rn = rsqrtf(ss * (1.f / 64.f) + 1e-6f) * (1.f - lam_init);
  const float* gp = P.in(15) + l * 64;
#pragma unroll
  for (int dt = 0; dt < 2; ++dt)
#pragma unroll
    for (int i = 0; i < 16; ++i) O0[dt][i] = O0[dt][i] * rn * gp[32 * dt + crow(i, h)];
  store_ot(Ob, tokbase + qw0, 768 + hd * 64, O0, lane, smem);
}

DI void moba_item(const Params& P0_, int b, int item, uchar* smem) {
  const KP P = kparams();
  const u16* H = (const u16*)(P.ws() + OFF_H);
  u16* Ob = (u16*)(P.ws() + OFF_O);
  const float* KM = (const float*)(P.ws() + OFF_KM);
  const int tid = otid(), lane = tid & 63, wave = tid >> 6, h = lane >> 5, r31 = lane & 31;
  const int qb = 31 - (item >> 2), hd = item & 3;
  const int q0 = qb * 128, qw0 = q0 + 32 * wave, qpos = qw0 + r31, cur = q0 >> 8;
  uchar* Ks = smem; uchar* Vs = smem + 9216; float* tab = (float*)(smem + 18432);
  float* kms = (float*)(smem + 18432 + 1024);
  unsigned* need = (unsigned*)(smem + 18432 + 1024 + 4096);
  __syncthreads();
  stage_bias(tab, P.in(2), 8 + hd);
  for (int i = tid; i < 16 * 64; i += NTHREADS) kms[i] = KM[((size_t)b * 16 + (i >> 6)) * 256 + hd * 64 + (i & 63)];
  if (tid == 0) *need = 0u;
  const size_t tokbase = (size_t)b * SL;
  bf16x8 qf[4];
  { const u16* qrow = H + (tokbase + qpos) * HC + C_Q + hd * 64;
#pragma unroll
    for (int s = 0; s < 4; ++s) qf[s] = *(const bf16x8*)(qrow + 16 * s + 8 * h); }
  __syncthreads();
  unsigned qmask = 0u;
  {
    float gate[16];
#pragma unroll
    for (int n = 0; n < 16; ++n) {
      float a = 0.f;
      if (n < cur) {
#pragma unroll
        for (int s = 0; s < 4; ++s)
#pragma unroll
          for (int j = 0; j < 8; ++j) a += bf2f((u16)qf[s][j]) * kms[n * 64 + 16 * s + 8 * h + j];
      }
      a += __shfl_xor(a, 32, 64);
      gate[n] = a;
    }
#pragma unroll
    for (int r = 0; r < 3; ++r) {
      float best = -INFINITY; int bi = -1;
#pragma unroll
      for (int n = 0; n < 16; ++n) if (n < cur && !((qmask >> n) & 1u) && gate[n] > best) { best = gate[n]; bi = n; }
      if (bi >= 0) qmask |= 1u << bi;
    }
    qmask |= 1u << cur;
  }
  unsigned wneed = 0u;
#pragma unroll
  for (int n = 0; n < 16; ++n) if (__builtin_amdgcn_ballot_w64((qmask >> n) & 1u) != 0ull) wneed |= 1u << n;
  if (lane == 0) atomicOr(need, wneed);
  __syncthreads();
  const unsigned bneed = *need;
  f32x16 O[2]; O[0] = zero16(); O[1] = zero16();
  float m = -1e30f, ls = 0.f;
  const float c2 = 0.125f * LOG2E;
  const int nt = (q0 + 127) / 64 + 1;
  KV_DECL;
  int t = 0;
  while (t < nt && !((bneed >> (t >> 2)) & 1u)) ++t;
  if (t < nt) KV_LOAD(H + (tokbase + t * 64) * HC + C_K + hd * 64, H + (tokbase + t * 64) * HC + C_V + hd * 64, HC);
  while (t < nt) {
    const int k0 = t * 64, jb = t >> 2;
    __syncthreads();
    KV_STORE();
    __syncthreads();
    int tn = t + 1;
    while (tn < nt && !((bneed >> (tn >> 2)) & 1u)) ++tn;
    if (tn < nt) KV_LOAD(H + (tokbase + tn * 64) * HC + C_K + hd * 64, H + (tokbase + tn * 64) * HC + C_V + hd * 64, HC);
    t = tn;
    if (((wneed >> jb) & 1u) && k0 <= qw0 + 31) {
      f32x16 st[2]; bf16x8 pf[4];
      qk_tile(st, qf, 0, 4, Ks, r31, h);
      const bool selq = (qmask >> jb) & 1u;
      if ((qw0 - (k0 + 63)) >= 128) {
        softmax_far<2>(st, c2, selq ? tab[128] : -INFINITY, m, ls, O, pf);
      } else {
#pragma unroll
        for (int kt = 0; kt < 2; ++kt)
#pragma unroll
          for (int i = 0; i < 16; ++i) {
            int dist = qpos - (k0 + 32 * kt + crow(i, h));
            st[kt][i] = (selq && dist >= 0) ? st[kt][i] * c2 + bias_at(tab, dist) : -INFINITY;
          }
        softmax_step<2>(st, m, ls, O, pf);
      }
      pv_tile(O, pf, Vs, lane);
    }
  }
  ls += __shfl_xor(ls, 32, 64);
  const float inv = ls > 0.f ? 1.f / ls : 0.f;
#pragma unroll
  for (int dt = 0; dt < 2; ++dt)
#pragma unroll
    for (int i = 0; i < 16; ++i) O[dt][i] *= inv;
  store_ot(Ob, tokbase + qw0, 512 + hd * 64, O, lane, smem);
}

DI void nsa_item(const Params& P0_, int b, int item, uchar* smem) {
  const KP P = kparams();
  const u16* H = (const u16*)(P.ws() + OFF_H);
  u16* Ob = (u16*)(P.ws() + OFF_O);
  const u16* KC = (const u16*)(P.ws() + OFF_KC);
  const u16* VC = (const u16*)(P.ws() + OFF_VC);
  const int tid = otid(), lane = tid & 63, wave = tid >> 6, h = lane >> 5, r31 = lane & 31;
  const int qb = 127 - item;
  const int q0 = qb * 32, qpos = q0 + r31, cur = q0 >> 6;
  uchar* Ks = smem; uchar* Vs = smem + 9216;
  float* tabs = (float*)(smem + 18432);
  float* imp = (float*)(smem + 18432 + 2112);
  unsigned* selm = (unsigned*)(smem + 18432 + 2112 + 32768);
  __syncthreads();
  for (int i = tid; i < 4 * 132; i += NTHREADS) { int w = i / 132, d = i % 132; tabs[i] = P.in(2)[BUCKET_LUT[d < 128 ? d : 128] * 16 + 4 + w] * LOG2E; }
  if (tid < 64) selm[tid] = 0u;
  const float* tab = tabs + wave * 132;
  const size_t tokbase = (size_t)b * SL;
  bf16x8 qf[4];
  { const u16* qrow = H + (tokbase + qpos) * HC + B_Q + wave * 64;
#pragma unroll
    for (int s = 0; s < 4; ++s) qf[s] = *(const bf16x8*)(qrow + 16 * s + 8 * h); }
  const float c2 = 0.125f * LOG2E;
  f32x16 acc[2];
  const u16* gp = H + (tokbase + qpos) * HC + B_G + wave * 3;
  {
    f32x16 O[4]; O[0] = zero16(); O[1] = zero16(); O[2] = zero16(); O[3] = zero16();
    float m = -1e30f, ls = 0.f;
    const int nmax = q0 / 16;
    const int ntl = (q0 >= 0 ? nmax / 64 + 1 : 0);
    for (int t = 0; t < ntl; ++t) {
      const int n0 = t * 64;
      __syncthreads();
      stage64(Ks, KC + ((size_t)b * 256 + n0) * 64, 64);
      stage64(Vs, VC + ((size_t)b * 256 + n0) * 64, 64);
      __syncthreads();
      f32x16 st[2]; bf16x8 pf[4];
      qk_tile(st, qf, 0, 4, Ks, r31, h);
#pragma unroll
      for (int kt = 0; kt < 2; ++kt)
#pragma unroll
        for (int i = 0; i < 16; ++i) {
          int n = n0 + 32 * kt + crow(i, h);
          st[kt][i] = (16 * n + 31 <= qpos) ? st[kt][i] * c2 : -INFINITY;
        }
      softmax_step<4, false>(st, m, ls, O, pf);
      pv_tile(O, pf, Vs, lane);
#pragma unroll
      for (int sp = 0; sp < 4; ++sp) {
#pragma unroll
        for (int u = 0; u < 2; ++u) {
          const int j = 32 * u + r31;
          bf16x8 of;
#pragma unroll
          for (int jj = 0; jj < 8; ++jj) {
            int n = n0 + 16 * sp + 8 * (jj >> 2) + 4 * h + (jj & 3);
            of[jj] = (n >= 4 * j - 1 && n <= 4 * j + 3) ? (short)0x3F80 : (short)0;
          }
          O[2 + u] = mfma32(of, pf[sp], O[2 + u]);
        }
      }
    }
    ls += __shfl_xor(ls, 32, 64);
    const float inv = ls > 0.f ? 1.f / ls : 0.f;
    const float ginv = inv / (1.f + __expf(-bf2f(gp[0])));
#pragma unroll
    for (int dt = 0; dt < 2; ++dt)
#pragma unroll
      for (int i = 0; i < 16; ++i) acc[dt][i] = ginv * O[dt][i];
#pragma unroll
    for (int u = 0; u < 2; ++u)
#pragma unroll
      for (int i = 0; i < 16; ++i) imp[(wave * 32 + r31) * 64 + 32 * u + crow(i, h)] = O[2 + u][i] * inv;
  }
  __syncthreads();
  {
    const int q = tid >> 3, jp = tid & 7, qp = q0 + q;
    float* row = imp + q * 64;
    float sv[8];
#pragma unroll
    for (int k = 0; k < 8; ++k) { int j = jp * 8 + k; sv[k] = imp[(0 * 32 + q) * 64 + j] + imp[(1 * 32 + q) * 64 + j] + imp[(2 * 32 + q) * 64 + j] + imp[(3 * 32 + q) * 64 + j]; }
    __syncthreads();
#pragma unroll
    for (int k = 0; k < 8; ++k) {
      int j = jp * 8 + k; float v = sv[k];
      if (j == 0 || j == cur || j == cur - 1) v = INFINITY;
      if (j * 64 > qp) v = -INFINITY;
      row[j] = v;
    }
    __syncthreads();
    unsigned bits = 0u;
#pragma unroll
    for (int k = 0; k < 8; ++k) {
      int j = jp * 8 + k; float v = row[j];
      int rank = 0;
      for (int j2 = 0; j2 < 64; ++j2) { float v2 = row[j2]; rank += (v2 > v || (v2 == v && j2 < j)) ? 1 : 0; }
      if (rank < 16 && j <= cur) bits |= 1u << k;
    }
    if (bits) atomicOr(&selm[q * 2 + (jp >> 2)], bits << ((jp & 3) * 8));
  }
  __syncthreads();
  const unsigned my_lo = selm[r31 * 2], my_hi = selm[r31 * 2 + 1];
  unsigned un_lo = 0u, un_hi = 0u;
  for (int q = 0; q < 32; ++q) { un_lo |= selm[q * 2]; un_hi |= selm[q * 2 + 1]; }
  KV_DECL;
  {
    f32x16 O[2]; O[0] = zero16v(); O[1] = zero16v();
    float m = -1e30f, ls = 0.f;
    const unsigned long long un = ((unsigned long long)un_hi << 32) | un_lo;
    int j = 0;
    while (j <= cur && !((un >> j) & 1ull)) ++j;
    if (j <= cur) KV_LOAD(H + (tokbase + j * 64) * HC + B_KS, H + (tokbase + j * 64) * HC + B_VS, HC);
    for (; j <= cur;) {
      const int k0 = j * 64;
      __syncthreads();
      KV_STORE();
      __syncthreads();
      int jn = j + 1;
      while (jn <= cur && !((un >> jn) & 1ull)) ++jn;
      if (jn <= cur) KV_LOAD(H + (tokbase + jn * 64) * HC + B_KS, H + (tokbase + jn * 64) * HC + B_VS, HC);
      const int jc = j; j = jn;
      const bool selq = jc < 32 ? ((my_lo >> jc) & 1u) : ((my_hi >> (jc - 32)) & 1u);
      f32x16 st[2]; bf16x8 pf[4];
      qk_tile(st, qf, 0, 4, Ks, r31, h);
      if ((q0 - (k0 + 63)) >= 128) {
        softmax_far<2, false>(st, c2, selq ? tab[128] : -INFINITY, m, ls, O, pf);
      } else {
#pragma unroll
        for (int kt = 0; kt < 2; ++kt)
#pragma unroll
          for (int i = 0; i < 16; ++i) {
            int dist = qpos - (k0 + 32 * kt + crow(i, h));
            st[kt][i] = (selq && dist >= 0) ? st[kt][i] * c2 + bias_at(tab, dist) : -INFINITY;
          }
        softmax_step<2, false>(st, m, ls, O, pf);
      }
      pv_tile(O, pf, Vs, lane);
    }
    ls += __shfl_xor(ls, 32, 64);
    const float inv = ls > 0.f ? 1.f / ls : 0.f;
    const float ginv = inv / (1.f + __expf(-bf2f(gp[1])));
#pragma unroll
    for (int dt = 0; dt < 2; ++dt)
#pragma unroll
      for (int i = 0; i < 16; ++i) acc[dt][i] += ginv * O[dt][i];
  }
  {
    f32x16 O[2]; O[0] = zero16v(); O[1] = zero16v();
    float m = -1e30f, ls = 0.f;
    int tlo = q0 - 511; tlo = tlo < 0 ? 0 : tlo >> 6;
    KV_LOAD(H + (tokbase + tlo * 64) * HC + B_KW, H + (tokbase + tlo * 64) * HC + B_VW, HC);
    for (int t = tlo; t <= cur; ++t) {
      const int k0 = t * 64;
      __syncthreads();
      KV_STORE();
      __syncthreads();
      if (t < cur) KV_LOAD(H + (tokbase + k0 + 64) * HC + B_KW, H + (tokbase + k0 + 64) * HC + B_VW, HC);
      f32x16 st[2]; bf16x8 pf[4];
      qk_tile(st, qf, 0, 4, Ks, r31, h);
      if ((q0 - (k0 + 63)) >= 128 && (q0 + 31 - k0) < 512) {
        softmax_far<2, false>(st, c2, tab[128], m, ls, O, pf);
      } else {
#pragma unroll
        for (int kt = 0; kt < 2; ++kt)
#pragma unroll
          for (int i = 0; i < 16; ++i) {
            int dist = qpos - (k0 + 32 * kt + crow(i, h));
            st[kt][i] = (dist >= 0 && dist < 512) ? st[kt][i] * c2 + bias_at(tab, dist) : -INFINITY;
          }
        softmax_step<2, false>(st, m, ls, O, pf);
      }
      pv_tile(O, pf, Vs, lane);
    }
    ls += __shfl_xor(ls, 32, 64);
    const float inv = ls > 0.f ? 1.f / ls : 0.f;
    const float ginv2 = inv / (1.f + __expf(-bf2f(gp[2])));
#pragma unroll
    for (int dt = 0; dt < 2; ++dt)
#pragma unroll
      for (int i = 0; i < 16; ++i) acc[dt][i] += ginv2 * O[dt][i];
  }
  store_ot(Ob, tokbase + q0, 256 + wave * 64, acc, lane, smem);
}

DI float gelu_tanh(float x) { float u = 0.7978845608028654f * (x + 0.044715f * x * x * x); return 0.5f * x * (1.f + tanhf(u)); }
DI void compress_item(const Params& P0_, int l, int item, uchar* smem) {
  const KP P = kparams();
  const u16* H = (const u16*)(P.ws() + OFF_H);
  const int tid = otid();
  const int which = item & 1, rest = item >> 1, b = rest & 7, grp = rest >> 3;
  const int nb = grp * 5;
  float* A = (float*)smem;
  float* part = (float*)(smem + 40960);
  float* gl = (float*)(smem + 40960 + 5120);
  const float* pos = P.in(which ? 6 : 5) + (size_t)l * 2048;
  const float* w1 = P.in(which ? 9 : 7) + (size_t)l * 2048 * 64;
  const float* w2 = P.in(which ? 10 : 8) + (size_t)l * 64 * 64;
  const int col = which ? B_VC : B_KC;
  __syncthreads();
  for (int e = tid; e < 5 * 2048; e += NTHREADS) {
    int r = e >> 11, k = e & 2047, t = k >> 6, d = k & 63;
    int tok = 16 * (nb + r) + t;
    A[e] = bf2f(H[((size_t)b * SL + tok) * HC + col + d]) + pos[k];
  }
  __syncthreads();
  const int j = tid & 63, pt = tid >> 6;
  float a[5] = {0.f, 0.f, 0.f, 0.f, 0.f};
  for (int k = pt * 512; k < pt * 512 + 512; ++k) {
    float wv = w1[(size_t)k * 64 + j];
#pragma unroll
    for (int r = 0; r < 5; ++r) a[r] += A[r * 2048 + k] * wv;
  }
#pragma unroll
  for (int r = 0; r < 5; ++r) part[(pt * 5 + r) * 64 + j] = a[r];
  __syncthreads();
  for (int e = tid; e < 320; e += NTHREADS) {
    int r = e >> 6, jj = e & 63;
    float s = part[(0 * 5 + r) * 64 + jj] + part[(1 * 5 + r) * 64 + jj] + part[(2 * 5 + r) * 64 + jj] + part[(3 * 5 + r) * 64 + jj];
    gl[r * 64 + jj] = gelu_tanh(s);
  }
  __syncthreads();
  u16* dst = (u16*)(P.ws() + (which ? OFF_VC : OFF_KC));
  for (int e = tid; e < 320; e += NTHREADS) {
    int r = e >> 6, jj = e & 63;
    float s = 0.f;
    for (int i = 0; i < 64; ++i) s += gl[r * 64 + i] * w2[i * 64 + jj];
    dst[((size_t)b * 256 + nb + r) * 64 + jj] = f2bf(s);
  }
  if (grp == 50) { for (int e = tid; e < 64; e += NTHREADS) dst[((size_t)b * 256 + 255) * 64 + e] = 0; }
}
DI void kmean_item(const Params& P0_, int item, uchar* smem) {
  const KP P = kparams();
  const u16* H = (const u16*)(P.ws() + OFF_H);
  float* KM = (float*)(P.ws() + OFF_KM);
  const int tid = otid(), lane = tid & 63, wave = tid >> 6;
  const int b = item >> 4, blk = item & 15;
  float* part = (float*)smem;
  float a0 = 0.f, a1 = 0.f, a2 = 0.f, a3 = 0.f;
  const u16* p = H + ((size_t)b * SL + blk * 256 + wave * 64) * HC + C_K + lane * 4;
#pragma unroll 16
  for (int t = 0; t < 64; ++t) {
    uint2 v = *(const uint2*)(p + (size_t)t * HC);
    a0 += bflo(v.x); a1 += bfhi(v.x); a2 += bflo(v.y); a3 += bfhi(v.y);
  }
  __syncthreads();
  part[wave * 256 + lane * 4 + 0] = a0; part[wave * 256 + lane * 4 + 1] = a1; part[wave * 256 + lane * 4 + 2] = a2; part[wave * 256 + lane * 4 + 3] = a3;
  __syncthreads();
  KM[((size_t)b * 16 + blk) * 256 + tid] = (part[tid] + part[256 + tid] + part[512 + tid] + part[768 + tid]) * (1.f / 256.f);
}

DI unsigned sortable(float f) { unsigned u = __float_as_uint(f); return (u & 0x80000000u) ? ~u : (u | 0x80000000u); }
DI void dsa_item(const Params& P0_, int b, int item, uchar* smem) {
  const KP P = kparams();
  const u16* H = (const u16*)(P.ws() + OFF_H);
  u16* Ob = (u16*)(P.ws() + OFF_O);
  const int tid = otid(), lane = tid & 63, wave = tid >> 6, h = lane >> 5, r31 = lane & 31;
  const int qb = 1023 - item;
  const int q0 = qb * 4;
  const size_t tokbase = (size_t)b * SL;
  float* sc = (float*)smem;
  u16* sel = (u16*)(smem + 65536);
  float* tabs = (float*)(smem + 65536 + 2048);
  __syncthreads();
  {
    const int hidx = (r31 & 3) | (((r31 >> 3) & 1) << 2), ql = ((r31 >> 2) & 1) | (((r31 >> 4) & 1) << 1);
    bf16x8 af[4];
    const u16* arow = H + (tokbase + q0 + ql) * HC + A_QI + hidx * 64;
#pragma unroll
    for (int s = 0; s < 4; ++s) af[s] = *(const bf16x8*)(arow + 16 * s + 8 * h);
    float wa[8], wb[8];
    { const uint4 va = *(const uint4*)(H + (tokbase + q0 + h) * HC + A_W), vb = *(const uint4*)(H + (tokbase + q0 + h + 2) * HC + A_W);
      wa[0] = bflo(va.x); wa[1] = bfhi(va.x); wa[2] = bflo(va.y); wa[3] = bfhi(va.y); wa[4] = bflo(va.z); wa[5] = bfhi(va.z); wa[6] = bflo(va.w); wa[7] = bfhi(va.w);
      wb[0] = bflo(vb.x); wb[1] = bfhi(vb.x); wb[2] = bflo(vb.y); wb[3] = bfhi(vb.y); wb[4] = bflo(vb.z); wb[5] = bfhi(vb.z); wb[6] = bflo(vb.w); wb[7] = bfhi(vb.w); }
    const int nkt = (q0 + 3) / 32 + 1;
    const u16* KIF = (const u16*)(P.ws() + OFF_KIF);
    bf16x8 k0f, k1f, k2f, k3f;
    {
      const int c0 = wave < nkt ? wave : 0;
      const u16* krow = KIF + ((size_t)((tokbase >> 5) + c0) * 256 + lane) * 8;
      k0f = *(const bf16x8*)(krow); k1f = *(const bf16x8*)(krow + 512); k2f = *(const bf16x8*)(krow + 1024); k3f = *(const bf16x8*)(krow + 1536);
    }
    for (int c = wave; c < nkt; c += 4) {
      bf16x8 n0f = k0f, n1f = k1f, n2f = k2f, n3f = k3f;
      if (c + 4 < nkt) {
        const u16* krow = KIF + ((size_t)((tokbase >> 5) + c + 4) * 256 + lane) * 8;
        n0f = *(const bf16x8*)(krow); n1f = *(const bf16x8*)(krow + 512); n2f = *(const bf16x8*)(krow + 1024); n3f = *(const bf16x8*)(krow + 1536);
      }
      f32x16 a = zero16();
      a = mfma32(af[0], k0f, a); a = mfma32(af[1], k1f, a); a = mfma32(af[2], k2f, a); a = mfma32(af[3], k3f, a);
      float sa = 0.f, sb = 0.f;
#pragma unroll
      for (int i = 0; i < 8; ++i) { sa += fmaxf(a[i], 0.f) * wa[i]; sb += fmaxf(a[8 + i], 0.f) * wb[i]; }
      sc[h * 4096 + 32 * c + r31] = sa;
      sc[(h + 2) * 4096 + 32 * c + r31] = sb;
      k0f = n0f; k1f = n1f; k2f = n2f; k3f = n3f;
    }
  }
  __syncthreads();
  const int qpos = q0 + wave, nvalid = qpos + 1;
  int count;
  unsigned long long myw = 0ull;
  if (nvalid <= 256) {
    count = nvalid;
    const int rem = nvalid - 64 * lane;
    myw = rem >= 64 ? ~0ull : (rem <= 0 ? 0ull : ((1ull << rem) - 1ull));
  } else {
    unsigned u[64];
#pragma unroll
    for (int c = 0; c < 64; ++c) { int s = lane + 64 * c; u[c] = (s < nvalid) ? sortable(sc[wave * 4096 + s]) : 0u; }
    const int ng = (nvalid + 1023) >> 10;
    unsigned T = 0u;
    bool exact = false;
    for (int bit = 31; bit >= 0; --bit) {
      const unsigned cand = T | (1u << bit);
      int lc = 0;
#pragma unroll
      for (int g = 0; g < 4; ++g) {
        if (g < ng) {
#pragma unroll
          for (int c = 16 * g; c < 16 * g + 16; ++c) lc += (u[c] >= cand) ? 1 : 0;
        }
      }
      const int cnt = wave_sum_i(lc);
      if (cnt >= 256) T = cand;
      if (cnt == 256) { exact = true; break; }
    }
    if (exact) {
#pragma unroll
      for (int g = 0; g < 4; ++g) {
        if (g < ng) {
#pragma unroll
          for (int c = 16 * g; c < 16 * g + 16; ++c) { const unsigned long long bt = __builtin_amdgcn_ballot_w64(u[c] >= T); if (lane == c) myw = bt; }
        }
      }
    } else {
      int cgt = 0;
#pragma unroll
      for (int c = 0; c < 64; ++c) cgt += __builtin_popcountll(__builtin_amdgcn_ballot_w64(u[c] > T));
      const int need_eq = 256 - cgt;
      int eq_seen = 0;
#pragma unroll
      for (int c = 0; c < 64; ++c) {
        const bool gt = u[c] > T, eq = u[c] == T;
        const unsigned long long beq = __builtin_amdgcn_ballot_w64(eq);
        const int erank = eq_seen + (int)__builtin_amdgcn_mbcnt_hi((unsigned)(beq >> 32), __builtin_amdgcn_mbcnt_lo((unsigned)beq, 0u));
        const bool take = gt || (eq && erank < need_eq);
        const unsigned long long bt = __builtin_amdgcn_ballot_w64(take);
        if (lane == c) myw = bt;
        eq_seen += __builtin_popcountll(beq);
      }
    }
    count = 256;
  }
  (void)count;
  ((unsigned long long*)(P.ws() + OFF_SEL))[(tokbase + qpos) * 64 + lane] = myw;
}

DI void dsa_dense_item(const Params& P0_, int b, int item, uchar* smem) {
  const KP P = kparams();
  const u16* H = (const u16*)(P.ws() + OFF_H);
  u16* Ob = (u16*)(P.ws() + OFF_O);
  const int tid = otid(), lane = tid & 63, wave = tid >> 6, h = lane >> 5, r31 = lane & 31;
  const int qb = 31 - (item >> 2), hd = item & 3;
  const int q0 = qb * 128, qw0 = q0 + 32 * wave, qpos = qw0 + r31;
  uchar* Ks = smem; uchar* Vs = smem + 9216; float* tab = (float*)(smem + 18432);
  __syncthreads();
  stage_bias(tab, P.in(2), hd);
  const size_t tokbase = (size_t)b * SL;
  bf16x8 qf[4];
  { const u16* qrow = H + (tokbase + qpos) * HC + A_Q + hd * 64;
#pragma unroll
    for (int s = 0; s < 4; ++s) qf[s] = *(const bf16x8*)(qrow + 16 * s + 8 * h); }
  const unsigned long long* mrow = (const unsigned long long*)(P.ws() + OFF_SEL) + (tokbase + qpos) * 64;
  f32x16 O[2]; O[0] = zero16(); O[1] = zero16();
  float m = -1e30f, ls = 0.f;
  const float c2 = 0.125f * LOG2E;
  const int nt = (q0 + 127) / 64 + 1;
  KV_DECL;
  KV_LOAD(H + tokbase * HC + A_K + hd * 64, H + tokbase * HC + A_V + hd * 64, HC);
  unsigned long long mw = mrow[0];
  for (int t = 0; t < nt; ++t) {
    const int k0 = t * 64;
    __syncthreads();
    KV_STORE();
    __syncthreads();
    const unsigned long long mcur = mw;
    if (t + 1 < nt) { KV_LOAD(H + (tokbase + k0 + 64) * HC + A_K + hd * 64, H + (tokbase + k0 + 64) * HC + A_V + hd * 64, HC); mw = mrow[t + 1]; }
    if (k0 <= qw0 + 31) {
      f32x16 st[2]; bf16x8 pf[4];
      qk_tile(st, qf, 0, 4, Ks, r31, h);
      const unsigned mlo = (unsigned)mcur, mhi = (unsigned)(mcur >> 32);
      if ((qw0 - (k0 + 63)) >= 128) {
        const float bfar = tab[128];
#pragma unroll
        for (int kt = 0; kt < 2; ++kt)
#pragma unroll
          for (int i = 0; i < 16; ++i) {
            const unsigned mm = kt ? mhi : mlo;
            st[kt][i] = ((mm >> crow(i, h)) & 1u) ? st[kt][i] * c2 + bfar : -INFINITY;
          }
      } else {
#pragma unroll
        for (int kt = 0; kt < 2; ++kt)
#pragma unroll
          for (int i = 0; i < 16; ++i) {
            const unsigned mm = kt ? mhi : mlo;
            const int dist = qpos - (k0 + 32 * kt + crow(i, h));
            st[kt][i] = ((mm >> crow(i, h)) & 1u) ? st[kt][i] * c2 + bias_at(tab, dist) : -INFINITY;
          }
      }
      softmax_step<2>(st, m, ls, O, pf);
      pv_tile(O, pf, Vs, lane);
    }
  }
  ls += __shfl_xor(ls, 32, 64);
  const float inv = ls > 0.f ? 1.f / ls : 0.f;
#pragma unroll
  for (int dt = 0; dt < 2; ++dt)
#pragma unroll
    for (int i = 0; i < 16; ++i) O[dt][i] *= inv;
  store_ot(Ob, tokbase + qw0, hd * 64, O, lane, smem);
}

DI void dsa_gather_item(const Params& P0_, int b, int item, uchar* smem) {
  const KP P = kparams();
  const u16* H = (const u16*)(P.ws() + OFF_H);
  u16* Ob = (u16*)(P.ws() + OFF_O);
  const int tid = otid(), lane = tid & 63, wave = tid >> 6, l7 = lane & 7, kg = lane >> 3;
  const int hd = item >> 8, qg = 255 - (item & 255);
  const size_t tokbase = (size_t)b * SL;
  float* tab = (float*)smem;
  u16* selw = (u16*)(smem + 1024 + wave * 2048);
  float* plw = (float*)(smem + 1024 + wave * 2048 + 512);
  u16* pbw = (u16*)(smem + 1024 + wave * 2048 + 1536);
  __syncthreads();
  stage_bias(tab, P.in(2), hd);
  __syncthreads();
  const u16* kb = H + tokbase * HC + A_K + hd * 64 + l7 * 8;
  const u16* vb = H + tokbase * HC + A_V + hd * 64 + l7 * 8;
  for (int qi = 0; qi < 4; ++qi) {
    const int qpos = qg * 16 + wave * 4 + qi;
    const int count = qpos + 1 < 256 ? qpos + 1 : 256;
    {
      const u16* gsel = (const u16*)(P.ws() + OFF_SEL) + (tokbase + qpos) * 256;
      *(uint2*)(selw + lane * 4) = *(const uint2*)(gsel + lane * 4);
    }
    asm volatile("s_waitcnt lgkmcnt(0)" ::: "memory");
    const uint4 qv = *(const uint4*)(H + (tokbase + qpos) * HC + A_Q + hd * 64 + l7 * 8);
#pragma unroll 8
    for (int i = 0; i < 32; ++i) {
      const int kk = 8 * i + kg;
      const int idx = selw[kk];
      const uint4 kv = *(const uint4*)(kb + (size_t)idx * HC);
      float d = dot2bf(kv.x, qv.x, 0.f); d = dot2bf(kv.y, qv.y, d); d = dot2bf(kv.z, qv.z, d); d = dot2bf(kv.w, qv.w, d);
      d = red8(d);
      if (l7 == 0) plw[kk] = d;
    }
    {
      float lg[4];
#pragma unroll
      for (int c = 0; c < 4; ++c) { const int kk = lane + 64 * c; lg[c] = (kk < count) ? plw[kk] * (0.125f * LOG2E) + bias_at(tab, qpos - (int)selw[kk]) : -INFINITY; }
      float mx = fmaxf(fmaxf(lg[0], lg[1]), fmaxf(lg[2], lg[3]));
      mx = wave_max(mx);
      float sm = 0.f;
#pragma unroll
      for (int c = 0; c < 4; ++c) { lg[c] = __builtin_amdgcn_exp2f(lg[c] - mx); sm += lg[c]; }
      sm = wave_sum(sm);
      const float inv = 1.f / sm;
#pragma unroll
      for (int c = 0; c < 4; ++c) pbw[lane + 64 * c] = f2bf(lg[c] * inv);
    }
    asm volatile("s_waitcnt lgkmcnt(0)" ::: "memory");
    float a0 = 0.f, a1 = 0.f, a2 = 0.f, a3 = 0.f, a4 = 0.f, a5 = 0.f, a6 = 0.f, a7 = 0.f;
    const int nb = (count + 15) >> 4;
    const unsigned* sel32 = (const unsigned*)selw;
    const unsigned* pb32 = (const unsigned*)pbw;
#pragma unroll 4
    for (int i = 0; i < nb; ++i) {
      const int kp = 8 * i + kg;
      const unsigned ii = sel32[kp], pp = pb32[kp];
      const uint4 x = *(const uint4*)(vb + (size_t)(ii & 0xffffu) * HC);
      const uint4 y = *(const uint4*)(vb + (size_t)(ii >> 16) * HC);
      a0 = dot2bf(__builtin_amdgcn_perm(y.x, x.x, 0x05040100u), pp, a0); a1 = dot2bf(__builtin_amdgcn_perm(y.x, x.x, 0x07060302u), pp, a1);
      a2 = dot2bf(__builtin_amdgcn_perm(y.y, x.y, 0x05040100u), pp, a2); a3 = dot2bf(__builtin_amdgcn_perm(y.y, x.y, 0x07060302u), pp, a3);
      a4 = dot2bf(__builtin_amdgcn_perm(y.z, x.z, 0x05040100u), pp, a4); a5 = dot2bf(__builtin_amdgcn_perm(y.z, x.z, 0x07060302u), pp, a5);
      a6 = dot2bf(__builtin_amdgcn_perm(y.w, x.w, 0x05040100u), pp, a6); a7 = dot2bf(__builtin_amdgcn_perm(y.w, x.w, 0x07060302u), pp, a7);
    }
#pragma unroll
    for (int o = 8; o < 64; o <<= 1) {
      a0 += __shfl_xor(a0, o, 64); a1 += __shfl_xor(a1, o, 64); a2 += __shfl_xor(a2, o, 64); a3 += __shfl_xor(a3, o, 64);
      a4 += __shfl_xor(a4, o, 64); a5 += __shfl_xor(a5, o, 64); a6 += __shfl_xor(a6, o, 64); a7 += __shfl_xor(a7, o, 64);
    }
    if (kg == 0) {
      uint4 o; o.x = pack2(a0, a1); o.y = pack2(a2, a3); o.z = pack2(a4, a5); o.w = pack2(a6, a7);
      *(uint4*)(Ob + (tokbase + qpos) * DM + hd * 64 + l7 * 8) = o;
    }
  }
}

DI void cross_item(const Params& P0_, int b, int item, uchar* smem) {
  const KP P = kparams();
  const u16* Q = (const u16*)(P.ws() + OFF_H);
  const u16* KV = (const u16*)(P.ws() + OFF_KV);
  u16* Ob = (u16*)(P.ws() + OFF_O);
  const int tid = otid(), lane = tid & 63, wave = tid >> 6, h = lane >> 5, r31 = lane & 31;
  const int hd = (item >> 5) & 3, qb = item & 31;
  const int qpos = qb * 128 + wave * 32 + r31;
  const size_t tok = (size_t)b * SL + qpos;
  uchar* Ks = smem; uchar* Vs = smem + 33792;
  f32x16 O[8];
#pragma unroll
  for (int i = 0; i < 8; ++i) O[i] = zero16();
  float m = -1e30f, ls = 0.f;
  const u16* qrow = Q + ((size_t)(hd * (NT / 32) + ((size_t)b * SL + qb * 128 + wave * 32) / 32) * 16 * 64 + lane) * 8;
  const int blk = (lane >> 4) & 1, q4 = (lane & 15) >> 2, p4 = lane & 3;
  for (int t = 0; t < 4; ++t) {
    __syncthreads();
    for (int i = 0; i < 8; ++i) {
      int c = tid + 256 * i, row = c >> 5, kc = c & 31;
      const u16* src = KV + ((size_t)b * 256 + t * 64 + row) * 2048 + hd * 256 + kc * 8;
      *(uint4*)(Ks + row * 528 + kc * 16) = *(const uint4*)src;
      *(uint4*)(Vs + row * 528 + kc * 16) = *(const uint4*)(src + 1024);
    }
    __syncthreads();
    f32x16 st[2]; st[0] = zero16(); st[1] = zero16();
#pragma unroll 4
    for (int s = 0; s < 16; ++s) {
      bf16x8 qf = *(const bf16x8*)(qrow + s * 512);
#pragma unroll
      for (int kt = 0; kt < 2; ++kt) {
        bf16x8 kf = *(const bf16x8*)(Ks + (32 * kt + r31) * 528 + (2 * s + h) * 16);
        st[kt] = mfma32(kf, qf, st[kt]);
      }
    }
    bf16x8 pf[4];
    softmax_far<8>(st, 0.0625f * LOG2E, 0.f, m, ls, O, pf);
#pragma unroll
    for (int sp = 0; sp < 4; ++sp) {
#pragma unroll
      for (int dt = 0; dt < 8; ++dt) {
        const uchar* a = Vs + (16 * sp + 4 * h + q4) * 528 + 64 * dt + 32 * blk + 8 * p4;
        s16x4 lo = tr_read(a), hi = tr_read(a + 8 * 528);
        bf16x8 vf = __builtin_shufflevector(lo, hi, 0, 1, 2, 3, 4, 5, 6, 7);
        O[dt] = mfma32(vf, pf[sp], O[dt]);
      }
    }
  }
  ls += __shfl_xor(ls, 32, 64);
  const float inv = 1.f / ls;
  __syncthreads();
#pragma unroll
  for (int dt = 0; dt < 8; ++dt)
#pragma unroll
    for (int g = 0; g < 4; ++g) {
      uint2 o; o.x = pack2(O[dt][4 * g] * inv, O[dt][4 * g + 1] * inv); o.y = pack2(O[dt][4 * g + 2] * inv, O[dt][4 * g + 3] * inv);
      *(uint2*)(smem + (wave * 32 + r31) * 528 + (32 * dt + 8 * g + 4 * h) * 2) = o;
    }
  __syncthreads();
#pragma unroll 4
  for (int i = 0; i < 16; ++i) {
    const int id = tid + 256 * i, row = (id >> 2) & 127, c = ((id >> 9) << 2) | (id & 3);
    const uint4 v = *(const uint4*)(smem + row * 528 + c * 16);
    *(uint4*)(Ob + kblk(NT, (size_t)b * SL + qb * 128 + row, hd * 256 + c * 8)) = v;
  }
}


#ifdef NO_CMP
#define CALL_CMP(x)
#else
#define CALL_CMP(x) x
#endif
#ifdef NO_DSA
#define CALL_DSA(x)
#else
#define CALL_DSA(x) x
#endif
#ifdef NO_DIFF
#define CALL_DIFF(x)
#else
#define CALL_DIFF(x) x
#endif
#ifdef NO_MOBA
#define CALL_MOBA(x)
#else
#define CALL_MOBA(x) x
#endif
#ifdef NO_NSA
#define CALL_NSA(x)
#else
#define CALL_NSA(x) x
#endif
#ifdef NO_CROSS
#define CALL_CROSS(x)
#else
#define CALL_CROSS(x) x
#endif

#define XB_TMO      128
#define XB_XCNT(j)  (256  + 64 * (j))
#define XB_XSUB(j)  (1280 + 64 * (j))
#define XB_XGEN(j)  (2304 + 64 * (j))
#define XB_TOP      3328
#define XB_TOPGEN   3392
#define XB_SPIN_CAP (1u << 22)
#define LAS __attribute__((address_space(3)))
DI unsigned xb_ld(unsigned* p)              { return __hip_atomic_load(p, __ATOMIC_RELAXED, __HIP_MEMORY_SCOPE_AGENT); }
DI unsigned xb_add(unsigned* p, unsigned v) { return __hip_atomic_fetch_add(p, v, __ATOMIC_RELAXED, __HIP_MEMORY_SCOPE_AGENT); }
DI unsigned xb_xcc_id() { return (unsigned)__builtin_amdgcn_s_getreg((3 << 11) | 20) & 0xFu; }
#define XB_SPIN(cond, bar) do { unsigned _sp = 0; while (cond) { __builtin_amdgcn_s_sleep(1); \
    if ((++_sp & 255u) == 0u) { if (xb_ld(&(bar)[XB_TMO])) break; if (_sp > XB_SPIN_CAP) { atomicAdd(&(bar)[XB_TMO], 1u); break; } } } } while (0)
struct XcdBarrier { unsigned* bar; unsigned x; volatile LAS unsigned* st; };
DI XcdBarrier xcd_barrier_post(unsigned* bar, volatile LAS unsigned* st) {
  XcdBarrier b; b.bar = bar; b.x = xb_xcc_id(); b.st = st;
  if (threadIdx.x == 0) (void)xb_add(&bar[XB_XCNT(b.x)], 1u);
  return b;
}
DI void xcd_barrier_complete(unsigned* bar, unsigned x, unsigned& nloc, unsigned& nx) {
  const unsigned G = gridDim.x * gridDim.y * gridDim.z;
  unsigned sum, cnt, mine, sp = 0u;
  for (;;) {
    sum = 0u; cnt = 0u; mine = 0u;
#pragma unroll
    for (unsigned j = 0; j < 16; ++j) { const unsigned c = xb_ld(&bar[XB_XCNT(j)]); sum += c; cnt += (c > 0u) ? 1u : 0u; mine = (j == x) ? c : mine; }
    if (sum == G) break;
    __builtin_amdgcn_s_sleep(1);
    if ((++sp & 255u) == 0u) { if (xb_ld(&bar[XB_TMO])) break; if (sp > XB_SPIN_CAP) { atomicAdd(&bar[XB_TMO], 1u); break; } }
  }
  nloc = mine > 0u ? mine : 1u; nx = cnt > 0u ? cnt : 1u;
}
DI void xcd_barrier(const XcdBarrier& b) {
  asm volatile("s_waitcnt vmcnt(0)" ::: "memory");
  __syncthreads();
  if (threadIdx.x == 0) {
    unsigned* bar = b.bar;
    __builtin_amdgcn_s_waitcnt(0);
    unsigned nloc = b.st[0], nx = b.st[1];
    if (nloc == 0u) { xcd_barrier_complete(bar, b.x, nloc, nx); b.st[0] = nloc; b.st[1] = nx; }
    const unsigned old = xb_add(&bar[XB_XSUB(b.x)], 1u);
    const unsigned gen = old / nloc;
    if (old + 1u == (gen + 1u) * nloc) {
      __builtin_amdgcn_fence(__ATOMIC_RELEASE, "agent");
      asm volatile("s_waitcnt vmcnt(0)" ::: "memory");
      const unsigned og = xb_add(&bar[XB_TOP], 1u);
      const unsigned tg = og / nx;
      if (og + 1u == (tg + 1u) * nx) xb_add(&bar[XB_TOPGEN], 1u);
      else XB_SPIN(xb_ld(&bar[XB_TOPGEN]) == tg, bar);
      __builtin_amdgcn_fence(__ATOMIC_ACQUIRE, "agent");
      xb_add(&bar[XB_XGEN(b.x)], 1u);
      asm volatile("s_waitcnt vmcnt(0)" ::: "memory");
    } else {
      XB_SPIN(xb_ld(&bar[XB_XGEN(b.x)]) == gen, bar);
      __builtin_amdgcn_fence(__ATOMIC_ACQUIRE, "agent");
      asm volatile("s_waitcnt vmcnt(0)" ::: "memory");
    }
  }
  __syncthreads();
}

__global__ void __launch_bounds__(NTHREADS, 2) fwd_megakernel(Params PARG) {
  __shared__ __attribute__((aligned(16))) uchar smem[LDS_BYTES];
  __shared__ int s_slot;
  cg::grid_group grid = cg::this_grid();
  __shared__ uint4 xb_words;
  if (threadIdx.x == 0) xb_words = make_uint4(0u, 0u, 0u, 0u);
  __syncthreads();
  const XcdBarrier xb = xcd_barrier_post((unsigned*)(kparams().ws() + OFF_BAR), (volatile LAS unsigned*)&xb_words);
  {
    const KP P = kparams();
    uchar* ws = P.ws();
    convert_flat(P.in(0), (u16*)(ws + OFF_XB), (size_t)NT * DM);
    convert_flat(P.in(1), (u16*)(ws + OFF_MEMB), (size_t)2048 * 1024);
    convert_layer_weights(PARG, 0, smem);
  }
  grid.sync();
  for (int l = 0; l < DEPTH; ++l) {
    const KP P = kparams();
    uchar* ws = P.ws();
    const uchar* wts = ws + ((l & 1) ? OFF_WALT : 0);
    u16* Xb = (u16*)(ws + OFF_XB);
    u16* Hb = (u16*)(ws + OFF_H);
    u16* Ob = (u16*)(ws + OFF_O);
    unsigned* ctr = (unsigned*)(ws + OFF_CTR);
    float* X = P.out();
    for (int rep = 0; rep < REP_G; ++rep) {
    { LnArgs kq{nullptr, nullptr, nullptr, nullptr, (float2*)(ws + OFF_KIF), 0u};
      gemm_phase<EPI_BF16>(Xb, NT, (const u16*)(wts + W_IN), HC, NT, HC, DM, Hb, HC, nullptr, smem, 0, kq); }
    xcd_barrier(xb);
    }
    for (int rep = 0; rep < REP_P2; ++rep) {
      unsigned* c = ctr + l * 64 + 0 + rep * 32;
      const int n_cmp = 2 * 8 * 51, n_km = 128, n_kv = 128;
      for (;;) {
        int it = next_item(c, &s_slot);
        if (it >= n_cmp + n_km + n_kv) break;
        if (it < n_cmp) { CALL_CMP(compress_item(PARG, l, it, smem)); }
        else if (it < n_cmp + n_km) { kmean_item(PARG, it - n_cmp, smem); }
        else {
          const int t = it - n_cmp - n_km;
          __syncthreads();
          gemm_tile256<EPI_BF16>((const u16*)(ws + OFF_MEMB), 2048, (const u16*)(wts + W_XK), 2048, DM, (t >> 4) * 256, (t & 15) * 128, (u16*)(ws + OFF_KV), 2048, nullptr, smem);
        }
      }
      int att = 0, b = 0;
      for (;;) {
        int it = next_item_b(ctr + l * 64 + 8 + rep * 32, 1024, att, b, &s_slot);
        if (it < 0) break;
        CALL_DSA(dsa_item(PARG, b, it, smem));
      }
    }
    xcd_barrier(xb);
    for (int rep = 0; rep < REP_P3; ++rep) {
      int att = 0, b = 0;
      for (;;) {
        int it = next_item_b(ctr + l * 64 + 16 + rep * 32, 512, att, b, &s_slot);
        if (it < 0) break;
        if (it < 128) { CALL_DIFF(diff_item(PARG, l, b, it, smem)); }
        else if (it < 256) { CALL_DSA(dsa_dense_item(PARG, b, it - 128, smem)); }
        else if (it < 384) { CALL_MOBA(moba_item(PARG, b, it - 256, smem)); }
        else { CALL_NSA(nsa_item(PARG, b, it - 384, smem)); }
      }
    }
    xcd_barrier(xb);
    { LnArgs ln{P.in(16) + l * DM, P.in(17) + l * DM, nullptr, ctr + 256, (float2*)(ws + OFF_STATS), 8u * (unsigned)(l * 3 + 1)};
      gemm_phase<EPI_RESID>(Ob, NT, (const u16*)(wts + W_OUT), DM, NT, DM, DM, nullptr, DM, Xb, smem, 0, ln); }
    xcd_barrier(xb);
    gemm_phase<EPI_QF>(Xb, NT, (const u16*)(wts + W_XQ), DM, NT, DM, DM, Hb, DM, nullptr, smem, 0);
    xcd_barrier(xb);
    for (int rep = 0; rep < REP_X; ++rep) {
      int att = 0, b = 0;
      for (;;) {
        int it = next_item_b(ctr + l * 64 + 24 + rep * 32, 128, att, b, &s_slot);
        if (it < 0) break;
        CALL_CROSS(cross_item(PARG, b, it, smem));
      }
    }
    xcd_barrier(xb);
    { LnArgs ln{P.in(22) + l * DM, P.in(23) + l * DM, nullptr, ctr + 256, (float2*)(ws + OFF_STATS), 8u * (unsigned)(l * 3 + 2)};
      gemm_phase<EPI_RESID>(Ob, NT, (const u16*)(wts + W_XO), DM, NT, DM, DM, nullptr, DM, Xb, smem, 0, ln); }
    xcd_barrier(xb);
    for (int rep = 0; rep < REP_G; ++rep) {
    gemm_phase<EPI_RELU2>(Xb, NT, (const u16*)(wts + W_1), DFF, NT, DFF, DM, Hb, DFF, nullptr, smem, 0);
    xcd_barrier(xb);
    }
    { LnArgs ln{P.in(26) + l * DM, P.in(27) + l * DM, (l == DEPTH - 1) ? P.out() : nullptr, ctr + 256, (float2*)(ws + OFF_STATS), 8u * (unsigned)(l * 3 + 3)};
      gemm_phase<EPI_RESID>(Hb, NT, (const u16*)(wts + W_2), DM, NT, DM, DFF, nullptr, DM, Xb, smem, 0, ln); }
    if (l + 1 < DEPTH) convert_layer_weights(PARG, l + 1, smem);
    xcd_barrier(xb);
  }
}

extern "C" void kernel_launch(void* const* d_in, const int* in_sizes, int n_in, void* d_out, int out_size, void* d_ws, size_t ws_size,
                              hipStream_t stream) {
  static int grid_blocks = 0;
  if (!grid_blocks) {
    int dev = 0, cus = 0, per_cu = 0;
    hipGetDevice(&dev);
    hipDeviceGetAttribute(&cus, hipDeviceAttributeMultiprocessorCount, dev);
    hipOccupancyMaxActiveBlocksPerMultiprocessor(&per_cu, fwd_megakernel, NTHREADS, 0);
    if (per_cu < 1) per_cu = 1;
    if (per_cu > 2) per_cu = 2;
    grid_blocks = cus * per_cu;
    if (ws_size < WS_END) fprintf(stderr, "workspace too small: %zu < %zu\n", ws_size, (size_t)WS_END);
  }
  Params p{};
  for (int i = 0; i < 28; ++i) p.in[i] = (const float*)d_in[i];
  p.out = (float*)d_out;
  p.ws = (uchar*)d_ws;
  hipMemsetAsync((uchar*)d_ws + OFF_CTR, 0, CTR_BYTES + BAR_BYTES, stream);
  void* args[] = {&p};
  hipError_t e = hipLaunchCooperativeKernel((void*)fwd_megakernel, dim3(grid_blocks), dim3(NTHREADS), args, 0, stream);
  if (e != hipSuccess) fprintf(stderr, "cooperative launch failed: %s (grid %d)\n", hipGetErrorString(e), grid_blocks);
}
```

```cpp
#include <hip/hip_runtime.h>
#include <hip/hip_cooperative_groups.h>
#include <cstdio>
namespace cg = cooperative_groups;

typedef unsigned short u16;
typedef unsigned char uchar;
typedef short bf16x8 __attribute__((ext_vector_type(8)));
typedef short s16x4 __attribute__((ext_vector_type(4)));
typedef float f32x16 __attribute__((ext_vector_type(16)));

#define DI __device__ __forceinline__

constexpr int NB = 8, SL = 4096, DM = 1024, DEPTH = 4, NT = NB * SL;
constexpr int HC = 3584;
constexpr int IN_COLS = 3540;
constexpr int DFF = 4096;
constexpr int A_Q = 0, A_K = 256, A_V = 512, A_QI = 768, A_KI = 1280;
constexpr int B_Q = 1344, B_KC = 1600, B_VC = 1664, B_KS = 1728, B_VS = 1792, B_KW = 1856, B_VW = 1920;
constexpr int C_Q = 1984, C_K = 2240, C_V = 2496, D_Q = 2752, D_K = 3008, D_V = 3264, A_W = 3520, B_G = 3528;
constexpr float ALPHA = 1.681792830507429f;
constexpr int LDS_BYTES = 75776;
constexpr int NTHREADS = 256;
#define REP_G 1
#define REP_P2 1
#define REP_P3 1
#define REP_X 1

constexpr size_t W_IN = 0;
constexpr size_t W_OUT = W_IN + (size_t)HC * 1024 * 2;
constexpr size_t W_XQ = W_OUT + 2097152;
constexpr size_t W_XK = W_XQ + 2097152;
constexpr size_t W_XV = W_XK + 2097152;
constexpr size_t W_XO = W_XV + 2097152;
constexpr size_t W_1 = W_XO + 2097152;
constexpr size_t W_2 = W_1 + 8388608;
constexpr size_t W_END = W_2 + 8388608;
constexpr size_t OFF_XB = W_END;
constexpr size_t OFF_H = OFF_XB + (size_t)NT * 1024 * 2;
constexpr size_t OFF_O = OFF_H + (size_t)NT * 4096 * 2;
constexpr size_t OFF_MEMB = OFF_O + (size_t)NT * 1024 * 2;
constexpr size_t OFF_KV = OFF_MEMB + 2048 * 1024 * 2;
constexpr size_t OFF_KC = OFF_KV + 2048 * 2048 * 2;
constexpr size_t OFF_VC = OFF_KC + 8 * 256 * 64 * 2;
constexpr size_t OFF_KM = OFF_VC + 8 * 256 * 64 * 2;
constexpr size_t OFF_SEL = OFF_KM + 8 * 16 * 256 * 4;
constexpr size_t OFF_CTR = OFF_SEL + (size_t)NT * 256 * 2;
constexpr size_t CTR_BYTES = 2048;
constexpr size_t OFF_BAR = OFF_CTR + CTR_BYTES;
constexpr size_t BAR_BYTES = 3456 * 4;
constexpr size_t OFF_STATS = OFF_BAR + BAR_BYTES;
constexpr size_t OFF_KIF = OFF_STATS + (size_t)128 * 8 * 256 * 8;
constexpr size_t OFF_WALT = OFF_KIF + (size_t)NT * 64 * 2;
constexpr size_t WS_END = OFF_WALT + W_END;

struct Params {
  const float* in[28];
  float* out;
  uchar* ws;
};

typedef const Params __attribute__((address_space(4))) CParams;
struct KP {
  CParams* p;
  DI const float* in(int i) const { return p->in[i]; }
  DI float* out() const { return p->out; }
  DI uchar* ws() const { return p->ws; }
};
DI KP kparams() {
  KP k;
#if defined(__HIP_DEVICE_COMPILE__)
  k.p = (CParams*)__builtin_amdgcn_kernarg_segment_ptr();
  asm volatile("" : "+s"(k.p));
#else
  k.p = nullptr;
#endif
  return k;
}
__device__ const uchar BUCKET_LUT[132] = {0, 1, 2, 3, 4, 5, 6, 7, 8, 9, 10, 11, 12, 13, 14, 15, 16, 16, 16, 17, 17, 18, 18, 18, 19, 19, 19, 20, 20, 20, 20, 21, 21, 21, 21, 22, 22, 22, 22, 22, 23, 23, 23, 23, 23, 23, 24, 24, 24, 24, 24, 24, 25, 25, 25, 25, 25, 25, 25, 26, 26, 26, 26, 26, 26, 26, 26, 27, 27, 27, 27, 27, 27, 27, 27, 27, 27, 28, 28, 28, 28, 28, 28, 28, 28, 28, 28, 29, 29, 29, 29, 29, 29, 29, 29, 29, 29, 29, 29, 30, 30, 30, 30, 30, 30, 30, 30, 30, 30, 30, 30, 30, 30, 31, 31, 31, 31, 31, 31, 31, 31, 31, 31, 31, 31, 31, 31, 31, 31, 31, 31, 31};

DI int otid() { int t = threadIdx.x; asm volatile("" : "+v"(t)); return t; }
DI u16 f2bf(float x) { unsigned u = __float_as_uint(x); u += 0x7fffu + ((u >> 16) & 1u); return (u16)(u >> 16); }
typedef __bf16 bf16x2_t __attribute__((ext_vector_type(2)));
typedef float f32x2_t __attribute__((ext_vector_type(2)));
DI unsigned pack2(float a, float b) { f32x2_t x = {a, b}; return __builtin_bit_cast(unsigned, __builtin_convertvector(x, bf16x2_t)); }
DI float bf2f(u16 v) { return __uint_as_float(((unsigned)v) << 16); }
DI float bflo(unsigned v) { return __uint_as_float(v << 16); }
DI float bfhi(unsigned v) { return __uint_as_float(v & 0xffff0000u); }
DI f32x16 mfma32(bf16x8 a, bf16x8 b, f32x16 c) { return __builtin_amdgcn_mfma_f32_32x32x16_bf16(a, b, c, 0, 0, 0); }
DI f32x16 zero16() { f32x16 z; for (int i = 0; i < 16; ++i) z[i] = 0.f; return z; }
DI f32x16 zero16v() { float zz = 0.f; asm volatile("" : "+v"(zz)); f32x16 z; for (int i = 0; i < 16; ++i) z[i] = zz; return z; }
DI s16x4 tr_read(const uchar* p) {
  return __builtin_amdgcn_ds_read_tr16_b64_v4i16((s16x4 __attribute__((address_space(3)))*)(p));
}
DI bf16x8 pack8(const f32x16& x, int s) {
  uint4 p;
  p.x = pack2(x[8 * s + 0], x[8 * s + 1]); p.y = pack2(x[8 * s + 2], x[8 * s + 3]);
  p.z = pack2(x[8 * s + 4], x[8 * s + 5]); p.w = pack2(x[8 * s + 6], x[8 * s + 7]);
  return __builtin_bit_cast(bf16x8, p);
}
DI float wave_sum(float v) { for (int o = 32; o > 0; o >>= 1) v += __shfl_xor(v, o, 64); return v; }
DI float wave_max(float v) { for (int o = 32; o > 0; o >>= 1) v = fmaxf(v, __shfl_xor(v, o, 64)); return v; }

typedef __bf16 bf2_t __attribute__((ext_vector_type(2)));
typedef float f32x2 __attribute__((ext_vector_type(2)));
DI float dot2bf(unsigned a, unsigned b, float c) { return __builtin_amdgcn_fdot2_f32_bf16(__builtin_bit_cast(bf2_t, a), __builtin_bit_cast(bf2_t, b), c, false); }
DI float red8(float v) {
  v += __builtin_amdgcn_update_dpp(0.f, v, 0xB1, 0xf, 0xf, true);
  v += __builtin_amdgcn_update_dpp(0.f, v, 0x4E, 0xf, 0xf, true);
  v += __builtin_amdgcn_update_dpp(0.f, v, 0x141, 0xf, 0xf, true);
  return v;
}
DI int wave_sum_i(int v) {
  v += __builtin_amdgcn_update_dpp(0, v, 0xB1, 0xf, 0xf, true);
  v += __builtin_amdgcn_update_dpp(0, v, 0x4E, 0xf, 0xf, true);
  v += __builtin_amdgcn_update_dpp(0, v, 0x141, 0xf, 0xf, true);
  v += __builtin_amdgcn_update_dpp(0, v, 0x140, 0xf, 0xf, true);
  return __builtin_amdgcn_readlane(v, 0) + __builtin_amdgcn_readlane(v, 16) + __builtin_amdgcn_readlane(v, 32) + __builtin_amdgcn_readlane(v, 48);
}

DI int next_item(unsigned* ctr, int* s_slot) {
  __syncthreads();
  if (threadIdx.x == 0) *s_slot = (int)atomicAdd(ctr, 1u);
  __syncthreads();
  return *s_slot;
}


DI int next_item_b(unsigned* q8, int per_batch, int& att, int& b, int* s_slot) {
  for (;;) {
    if (att >= 8) return -1;
    b = (int)((blockIdx.x + att) & 7);
    int it = next_item(q8 + b, s_slot);
    if (it < per_batch) return it;
    ++att;
  }
}

DI void stage64(uchar* dst, const u16* src, size_t row_stride) {
  const int tid = otid();
#pragma unroll
  for (int i = 0; i < 2; ++i) {
    int c = tid + 256 * i, row = c >> 3, kc = c & 7;
    uint4 v = *(const uint4*)(src + (size_t)row * row_stride + kc * 8);
    *(uint4*)(dst + row * 144 + kc * 16) = v;
  }
}

DI void qk_tile(f32x16 st[2], const bf16x8* qf, int s0, int ns, const uchar* Ks, int r31, int h) {
#pragma unroll
  for (int kt = 0; kt < 2; ++kt) {
    st[kt] = zero16();
#pragma unroll
    for (int s = 0; s < ns; ++s) {
      bf16x8 kf = *(const bf16x8*)(Ks + (32 * kt + r31) * 144 + (2 * (s0 + s) + h) * 16);
      st[kt] = mfma32(kf, qf[s0 + s], st[kt]);
    }
  }
}

DI void pv_tile(f32x16 O[2], const bf16x8 pf[4], const uchar* Vs, int lane) {
  const int h = lane >> 5, blk = (lane >> 4) & 1, q4 = (lane & 15) >> 2, p = lane & 3;
#pragma unroll
  for (int sp = 0; sp < 4; ++sp) {
#pragma unroll
    for (int dt = 0; dt < 2; ++dt) {
      const uchar* a = Vs + (16 * sp + 4 * h + q4) * 144 + 64 * dt + 32 * blk + 8 * p;
      s16x4 lo = tr_read(a), hi = tr_read(a + 8 * 144);
      bf16x8 vf = __builtin_shufflevector(lo, hi, 0, 1, 2, 3, 4, 5, 6, 7);
      O[dt] = mfma32(vf, pf[sp], O[dt]);
    }
  }
}

constexpr float LOG2E = 1.4426950408889634f;
template <int NO, bool COND>
DI void sm_rescale(float& m, float mx, float& lsum, f32x16* O) {
  if (!COND || __builtin_amdgcn_ballot_w64(mx > m) != 0ull) {
    const float corr = __builtin_amdgcn_exp2f(m - mx);
    lsum *= corr;
#pragma unroll
    for (int o = 0; o < NO; ++o)
#pragma unroll
      for (int i = 0; i < 16; ++i) O[o][i] *= corr;
  }
  m = mx;
}
DI float max16(const f32x16& x) {
  float a = fmaxf(fmaxf(x[0], x[1]), x[2]), b = fmaxf(fmaxf(x[3], x[4]), x[5]), c = fmaxf(fmaxf(x[6], x[7]), x[8]);
  float d = fmaxf(fmaxf(x[9], x[10]), x[11]), e = fmaxf(fmaxf(x[12], x[13]), x[14]);
  return fmaxf(fmaxf(fmaxf(a, b), fmaxf(c, d)), fmaxf(e, x[15]));
}
template <int NO, bool COND = true>
DI void softmax_step(f32x16 st[2], float& m, float& lsum, f32x16* O, bf16x8 pf[4]) {
  float mx = fmaxf(m, fmaxf(max16(st[0]), max16(st[1])));
  mx = fmaxf(mx, __shfl_xor(mx, 32, 64));
  sm_rescale<NO, COND>(m, mx, lsum, O);
#pragma unroll
  for (int kt = 0; kt < 2; ++kt)
#pragma unroll
    for (int i = 0; i < 16; ++i) { float p = __builtin_amdgcn_exp2f(st[kt][i] - mx); lsum += p; st[kt][i] = p; }
#pragma unroll
  for (int kt = 0; kt < 2; ++kt) { pf[2 * kt] = pack8(st[kt], 0); pf[2 * kt + 1] = pack8(st[kt], 1); }
}
template <int NO, bool COND = true>
DI void softmax_far(f32x16 st[2], float c2, float b2, float& m, float& lsum, f32x16* O, bf16x8 pf[4]) {
  float mr = fmaxf(max16(st[0]), max16(st[1]));
  float mx = fmaxf(m, mr * c2 + b2);
  mx = fmaxf(mx, __shfl_xor(mx, 32, 64));
  sm_rescale<NO, COND>(m, mx, lsum, O);
  const float off = b2 - mx;
#pragma unroll
  for (int kt = 0; kt < 2; ++kt)
#pragma unroll
    for (int i = 0; i < 16; ++i) { float p = __builtin_amdgcn_exp2f(__builtin_fmaf(st[kt][i], c2, off)); lsum += p; st[kt][i] = p; }
#pragma unroll
  for (int kt = 0; kt < 2; ++kt) { pf[2 * kt] = pack8(st[kt], 0); pf[2 * kt + 1] = pack8(st[kt], 1); }
}

DI int crow(int i, int h) { return (i & 3) + 8 * (i >> 2) + 4 * h; }

DI int colmap_in(int n) {
  if (n < 1344) return n;
  if (n < 1984) return n + 8;
  if (n < 3520) return n + 20;
  if (n < 3528) return 1344 + (n - 3520);
  if (n < 3540) return 1992 + (n - 3528);
  return -1;
}
DI void transpose_convert(const float* __restrict__ src, int K, int Nsrc, u16* __restrict__ dst, int Ndst, bool remap, uchar* smem, int Ntot = 0, int nofs = 0) {
  if (Ntot == 0) Ntot = Ndst;
  float* tile = (float*)smem;
  const int tid = otid();
  const int nkt = K / 64, ntiles = (Ndst / 64) * nkt;
  for (int t = blockIdx.x; t < ntiles; t += gridDim.x) {
    const int kt = t % nkt, nt = t / nkt;
    __syncthreads();
#pragma unroll 4
    for (int i = 0; i < 16; ++i) {
      int e = tid + 256 * i, r = e >> 6, c = e & 63;
      int n = nt * 64 + c;
      int sc = remap ? colmap_in(n) : n;
      float v = sc >= 0 ? src[(size_t)(kt * 64 + r) * Nsrc + sc] : 0.f;
      tile[r * 65 + c] = v;
    }
    __syncthreads();
#pragma unroll
    for (int i = 0; i < 2; ++i) {
      int e = tid + 256 * i, n = e >> 3, kc = e & 7;
      uint4 o;
      o.x = pack2(tile[(kc * 8 + 0) * 65 + n], tile[(kc * 8 + 1) * 65 + n]);
      o.y = pack2(tile[(kc * 8 + 2) * 65 + n], tile[(kc * 8 + 3) * 65 + n]);
      o.z = pack2(tile[(kc * 8 + 4) * 65 + n], tile[(kc * 8 + 5) * 65 + n]);
      o.w = pack2(tile[(kc * 8 + 6) * 65 + n], tile[(kc * 8 + 7) * 65 + n]);
      *(uint4*)(dst + ((size_t)(kt * 2 + (kc >> 2)) * Ntot + nofs + nt * 64 + n) * 32 + (kc & 3) * 8) = o;
    }
  }
}

DI void convert_layer_weights(const Params& P0_, int l, uchar* smem) {
  const KP P = kparams();
  uchar* ws = P.ws() + ((l & 1) ? OFF_WALT : 0);
  transpose_convert(P.in(3) + (size_t)l * 1024 * IN_COLS, 1024, IN_COLS, (u16*)(ws + W_IN), HC, true, smem);
  transpose_convert(P.in(4) + (size_t)l * 1024 * 1024, 1024, 1024, (u16*)(ws + W_OUT), 1024, false, smem);
  transpose_convert(P.in(18) + (size_t)l * 1024 * 1024, 1024, 1024, (u16*)(ws + W_XQ), 1024, false, smem);
  transpose_convert(P.in(19) + (size_t)l * 1024 * 1024, 1024, 1024, (u16*)(ws + W_XK), 1024, false, smem, 2048, 0);
  transpose_convert(P.in(20) + (size_t)l * 1024 * 1024, 1024, 1024, (u16*)(ws + W_XK), 1024, false, smem, 2048, 1024);
  transpose_convert(P.in(21) + (size_t)l * 1024 * 1024, 1024, 1024, (u16*)(ws + W_XO), 1024, false, smem);
  transpose_convert(P.in(24) + (size_t)l * 1024 * DFF, 1024, DFF, (u16*)(ws + W_1), DFF, false, smem);
  transpose_convert(P.in(25) + (size_t)l * DFF * 1024, DFF, 1024, (u16*)(ws + W_2), 1024, false, smem);
}

DI size_t kblk(size_t M, size_t m, int k) { return ((size_t)(k >> 5) * M + m) * 32 + (k & 31); }
DI void convert_flat(const float* __restrict__ src, u16* __restrict__ dst, size_t n) {
  size_t nv = n / 8;
  for (size_t i = (size_t)blockIdx.x * NTHREADS + threadIdx.x; i < nv; i += (size_t)gridDim.x * NTHREADS) {
    float4 a = *(const float4*)(src + i * 8), b = *(const float4*)(src + i * 8 + 4);
    uint4 o; o.x = pack2(a.x, a.y); o.y = pack2(a.z, a.w); o.z = pack2(b.x, b.y); o.w = pack2(b.z, b.w);
    const size_t e = i * 8, m = e >> 10; const int k = (int)(e & 1023);
    *(uint4*)(dst + kblk(n >> 10, m, k)) = o;
  }
}

enum { EPI_BF16 = 0, EPI_RELU2 = 1, EPI_RESID = 2, EPI_QF = 3 };
struct LnArgs { const float* g; const float* b; float* fout; unsigned* flags; float2* stats; unsigned target; };
template <int EPI>
DI void gemm_tile256(const u16* __restrict__ A, int lda, const u16* __restrict__ Bt, int ldb, int K, int m0, int n0,
                     void* Cout, int ldc, const u16* Xres, uchar* smem, LnArgs ln = LnArgs{}) {
  const int tid = otid(), lane = tid & 63, wave = tid >> 6, wr = wave >> 1, wc = wave & 1, h = lane >> 5, r31 = lane & 31;
  f32x16 acc[4][2];
#pragma unroll
  for (int a = 0; a < 4; ++a)
#pragma unroll
    for (int b = 0; b < 2; ++b) acc[a][b] = zero16();
  const int nk = K / 32;
  constexpr int SB = 24576, BO = 16384;
  const int gc = (tid & 3) ^ ((tid >> 4) & 3);
  const u16* Ap = A + (size_t)(m0 + (tid >> 2)) * 32 + gc * 8;
  const u16* Bp = Bt + (size_t)(n0 + (tid >> 2)) * 32 + gc * 8;
#define STAGE(buf, ko) do { uchar* d_ = smem + (buf) * SB + tid * 16; \
    __builtin_amdgcn_global_load_lds((const unsigned*)(Ap + (size_t)(ko) * lda), (__attribute__((address_space(3))) unsigned*)(d_), 16, 0, 0); \
    __builtin_amdgcn_global_load_lds((const unsigned*)(Ap + (size_t)(ko) * lda + 64 * 32), (__attribute__((address_space(3))) unsigned*)(d_ + 4096), 16, 0, 0); \
    __builtin_amdgcn_global_load_lds((const unsigned*)(Ap + (size_t)(ko) * lda + 128 * 32), (__attribute__((address_space(3))) unsigned*)(d_ + 8192), 16, 0, 0); \
    __builtin_amdgcn_global_load_lds((const unsigned*)(Ap + (size_t)(ko) * lda + 192 * 32), (__attribute__((address_space(3))) unsigned*)(d_ + 12288), 16, 0, 0); \
    __builtin_amdgcn_global_load_lds((const unsigned*)(Bp + (size_t)(ko) * ldb), (__attribute__((address_space(3))) unsigned*)(d_ + 16384), 16, 0, 0); \
    __builtin_amdgcn_global_load_lds((const unsigned*)(Bp + (size_t)(ko) * ldb + 64 * 32), (__attribute__((address_space(3))) unsigned*)(d_ + 20480), 16, 0, 0); } while (0)
  const int fsw = (r31 >> 2) & 3;
  const int c0o = ((h) ^ fsw) * 16, c1o = ((2 + h) ^ fsw) * 16;
  const unsigned lds0 = (unsigned)(size_t)smem;
  const unsigned aoff = lds0 + (wr * 128 + r31) * 64, boff = lds0 + BO + (wc * 64 + r31) * 64;
#define COMPUTE(sbyte) do { \
      bf16x8 p0, p1, q0, q1, q2, q3, t0, t1, u0, u1, u2, u3; \
      const unsigned b0_ = boff + (sbyte) + c0o, a0_ = aoff + (sbyte) + c0o, b1_ = boff + (sbyte) + c1o, a1_ = aoff + (sbyte) + c1o; \
      asm volatile("ds_read_b128 %0, %12\n\tds_read_b128 %1, %12 offset:2048\n\t" \
                   "ds_read_b128 %2, %13\n\tds_read_b128 %3, %13 offset:2048\n\tds_read_b128 %4, %13 offset:4096\n\tds_read_b128 %5, %13 offset:6144\n\t" \
                   "ds_read_b128 %6, %14\n\tds_read_b128 %7, %14 offset:2048\n\t" \
                   "ds_read_b128 %8, %15\n\tds_read_b128 %9, %15 offset:2048\n\tds_read_b128 %10, %15 offset:4096\n\tds_read_b128 %11, %15 offset:6144\n\t" \
                   "s_waitcnt lgkmcnt(0)" \
                   : "=&v"(p0), "=&v"(p1), "=&v"(q0), "=&v"(q1), "=&v"(q2), "=&v"(q3), "=&v"(t0), "=&v"(t1), "=&v"(u0), "=&v"(u1), "=&v"(u2), "=&v"(u3) \
                   : "v"(b0_), "v"(a0_), "v"(b1_), "v"(a1_) : "memory"); \
      acc[0][0] = mfma32(p0, q0, acc[0][0]); acc[0][1] = mfma32(p1, q0, acc[0][1]); \
      acc[1][0] = mfma32(p0, q1, acc[1][0]); acc[1][1] = mfma32(p1, q1, acc[1][1]); \
      acc[2][0] = mfma32(p0, q2, acc[2][0]); acc[2][1] = mfma32(p1, q2, acc[2][1]); \
      acc[3][0] = mfma32(p0, q3, acc[3][0]); acc[3][1] = mfma32(p1, q3, acc[3][1]); \
      acc[0][0] = mfma32(t0, u0, acc[0][0]); acc[0][1] = mfma32(t1, u0, acc[0][1]); \
      acc[1][0] = mfma32(t0, u1, acc[1][0]); acc[1][1] = mfma32(t1, u1, acc[1][1]); \
      acc[2][0] = mfma32(t0, u2, acc[2][0]); acc[2][1] = mfma32(t1, u2, acc[2][1]); \
      acc[3][0] = mfma32(t0, u3, acc[3][0]); acc[3][1] = mfma32(t1, u3, acc[3][1]); \
      } while (0)
  __syncthreads();
  STAGE(0, 0);
  STAGE(1, 32);
  int cb = 0;
  for (int kt = 0; kt < nk; ++kt) {
    if (kt + 1 < nk) asm volatile("s_waitcnt vmcnt(6)" ::: "memory"); else asm volatile("s_waitcnt vmcnt(0)" ::: "memory");
    __builtin_amdgcn_s_barrier();
    if (kt + 2 < nk) { const int nb = cb >= 1 ? cb - 1 : 2; STAGE(nb, (kt + 2) * 32); }
    COMPUTE(cb * SB);
    cb = cb == 2 ? 0 : cb + 1;
  }
  __syncthreads();
#undef STAGE
#undef COMPUTE
  if (EPI == EPI_RESID) {
    const int mt = m0 >> 8, nt = n0 >> 7;
    float2* myst = ln.stats + (size_t)(mt * 8 + nt) * 256;
    float2* rowstat = (float2*)(smem + 67584);
#define STAGE_HALF(hf) do { if (wr == (hf)) { \
      _Pragma("unroll") for (int mi = 0; mi < 4; ++mi) _Pragma("unroll") for (int ni = 0; ni < 2; ++ni) _Pragma("unroll") for (int g = 0; g < 4; ++g) { \
        float4 v; v.x = acc[mi][ni][4 * g]; v.y = acc[mi][ni][4 * g + 1]; v.z = acc[mi][ni][4 * g + 2]; v.w = acc[mi][ni][4 * g + 3]; \
        *(float4*)(smem + (mi * 32 + r31) * 528 + (wc * 64 + ni * 32 + 8 * g + 4 * h) * 4) = v; } } \
      __syncthreads(); } while (0)
#pragma unroll
    for (int hf = 0; hf < 2; ++hf) {
      STAGE_HALF(hf);
#pragma unroll 4
      for (int i = 0; i < 16; ++i) {
        const int id = tid + 256 * i, row = (id >> 3) & 127, c = ((id >> 10) << 3) | (id & 7);
        float4* sp = (float4*)(smem + row * 528 + c * 16);
        const float4 v = *sp;
        const uint2 xb = *(const uint2*)(Xres + kblk(NT, (size_t)(m0 + hf * 128 + row), n0 + c * 4));
        float4 y; y.x = ALPHA * bflo(xb.x) + v.x; y.y = ALPHA * bfhi(xb.x) + v.y; y.z = ALPHA * bflo(xb.y) + v.z; y.w = ALPHA * bfhi(xb.y) + v.w;
        *sp = y;
      }
      __syncthreads();
      if (tid < 128) {
        float sa = 0.f, sq = 0.f;
#pragma unroll 8
        for (int c = 0; c < 32; ++c) {
          const float4 y = *(const float4*)(smem + tid * 528 + c * 16);
          sa += (y.x + y.y) + (y.z + y.w); sq += (y.x * y.x + y.y * y.y) + (y.z * y.z + y.w * y.w);
        }
        __hip_atomic_store((unsigned*)&myst[hf * 128 + tid].x, __float_as_uint(sa), __ATOMIC_RELAXED, __HIP_MEMORY_SCOPE_AGENT);
        __hip_atomic_store((unsigned*)&myst[hf * 128 + tid].y, __float_as_uint(sq), __ATOMIC_RELAXED, __HIP_MEMORY_SCOPE_AGENT);
      }
      __syncthreads();
    }
    asm volatile("s_waitcnt vmcnt(0)" ::: "memory");
    __syncthreads();
    if (threadIdx.x == 0) {
      (void)__hip_atomic_fetch_add(ln.flags + mt, 1u, __ATOMIC_RELAXED, __HIP_MEMORY_SCOPE_AGENT);
      unsigned sp = 0u;
      while (__hip_atomic_load(ln.flags + mt, __ATOMIC_RELAXED, __HIP_MEMORY_SCOPE_AGENT) < ln.target) { __builtin_amdgcn_s_sleep(1); if (++sp > (1u << 24)) break; }
    }
    __syncthreads();
    {
      float sa = 0.f, sq = 0.f;
#pragma unroll
      for (int k = 0; k < 8; ++k) {
        const float2* pp = ln.stats + (size_t)(mt * 8 + k) * 256 + tid;
        sa += __uint_as_float(__hip_atomic_load((const unsigned*)&pp->x, __ATOMIC_RELAXED, __HIP_MEMORY_SCOPE_AGENT));
        sq += __uint_as_float(__hip_atomic_load((const unsigned*)&pp->y, __ATOMIC_RELAXED, __HIP_MEMORY_SCOPE_AGENT));
      }
      const float mu = sa * (1.f / 1024.f);
      const float var = sq * (1.f / 1024.f) - mu * mu;
      rowstat[tid] = make_float2(mu, rsqrtf(fmaxf(var, 0.f) + 1e-5f));
    }
#pragma unroll
    for (int hf = 0; hf < 2; ++hf) {
      STAGE_HALF(hf);
#pragma unroll 4
      for (int i = 0; i < 16; ++i) {
        const int id = tid + 256 * i, row = (id >> 3) & 127, c = ((id >> 10) << 3) | (id & 7);
        const float4 v = *(const float4*)(smem + row * 528 + c * 16);
        const size_t go = kblk(NT, (size_t)(m0 + hf * 128 + row), n0 + c * 4);
        const uint2 xb = *(const uint2*)(Xres + go);
        const float2 rs = rowstat[hf * 128 + row];
        const float4 g4 = *(const float4*)(ln.g + n0 + c * 4), b4 = *(const float4*)(ln.b + n0 + c * 4);
        float4 o;
        o.x = (ALPHA * bflo(xb.x) + v.x - rs.x) * rs.y * g4.x + b4.x; o.y = (ALPHA * bfhi(xb.x) + v.y - rs.x) * rs.y * g4.y + b4.y;
        o.z = (ALPHA * bflo(xb.y) + v.z - rs.x) * rs.y * g4.z + b4.z; o.w = (ALPHA * bfhi(xb.y) + v.w - rs.x) * rs.y * g4.w + b4.w;
        uint2 ob; ob.x = pack2(o.x, o.y); ob.y = pack2(o.z, o.w);
        *(uint2*)((u16*)Xres + go) = ob;
        if (ln.fout) *(float4*)(ln.fout + (size_t)(m0 + hf * 128 + row) * ldc + n0 + c * 4) = o;
      }
      __syncthreads();
    }
#undef STAGE_HALF
  } else {
#pragma unroll
    for (int mi = 0; mi < 4; ++mi)
#pragma unroll
      for (int ni = 0; ni < 2; ++ni)
#pragma unroll
        for (int g = 0; g < 4; ++g) {
          float v0 = acc[mi][ni][4 * g], v1 = acc[mi][ni][4 * g + 1], v2 = acc[mi][ni][4 * g + 2], v3 = acc[mi][ni][4 * g + 3];
          if (EPI == EPI_RELU2) { v0 = fmaxf(v0, 0.f); v0 *= v0; v1 = fmaxf(v1, 0.f); v1 *= v1; v2 = fmaxf(v2, 0.f); v2 *= v2; v3 = fmaxf(v3, 0.f); v3 *= v3; }
          uint2 o; o.x = pack2(v0, v1); o.y = pack2(v2, v3);
          *(uint2*)(smem + (wr * 128 + mi * 32 + r31) * 272 + (wc * 64 + ni * 32 + 8 * g + 4 * h) * 2) = o;
        }
    __syncthreads();
#pragma unroll 4
    for (int i = 0; i < 16; ++i) {
      if (EPI == EPI_QF) {
        const int id = tid + 256 * i, ln64 = id & 63, ks = (id >> 6) & 7, kt8 = id >> 9;
        const uint4 v = *(const uint4*)(smem + (kt8 * 32 + (ln64 & 31)) * 272 + (2 * ks + (ln64 >> 5)) * 16);
        const size_t piece = ((size_t)((n0 >> 8) * (NT / 32) + (m0 >> 5) + kt8) * 16 + ((n0 & 255) >> 4) + ks) * 64 + ln64;
        *(uint4*)((u16*)Cout + piece * 8) = v;
      } else if (EPI == EPI_RELU2) {
        const int id = tid + 256 * i, row = (id >> 2) & 255, c = ((id >> 10) << 2) | (id & 3);
        const uint4 v = *(const uint4*)(smem + row * 272 + c * 16);
        *(uint4*)((u16*)Cout + kblk(NT, (size_t)(m0 + row), n0 + c * 8)) = v;
      } else {
      const int id = tid + 256 * i, row = id >> 4, c = id & 15;
      const uint4 v = *(const uint4*)(smem + row * 272 + c * 16);
      *(uint4*)((u16*)Cout + (size_t)(m0 + row) * ldc + n0 + c * 8) = v;
      }
    }
    if (EPI == EPI_BF16 && ldc == HC && n0 == A_KI && ln.stats) {
      u16* kif = (u16*)ln.stats;
#pragma unroll 4
      for (int i = 0; i < 8; ++i) {
        const int id = tid + 256 * i, ln64 = id & 63, ks = (id >> 6) & 3, kt8 = id >> 8;
        const uint4 v = *(const uint4*)(smem + (kt8 * 32 + (ln64 & 31)) * 272 + (2 * ks + (ln64 >> 5)) * 16);
        *(uint4*)(kif + ((size_t)(((m0 >> 5) + kt8) * 4 + ks) * 64 + ln64) * 8) = v;
      }
    }
    __syncthreads();
  }
}

template <int EPI>
DI void gemm_phase(const u16* A, int lda, const u16* Bt, int ldb, int M, int N, int K, void* C, int ldc, const u16* Xres, uchar* smem,
                           int xoff, LnArgs ln = LnArgs{}) {
  const int nN = N / 128, nM = M / 256;
  const int PC = (nN % 8 == 0) ? 8 : 4, PR = 64 / PC;
  const int npc = nN / PC, npatch = (nM / PR) * npc;
  const int x = (int)((blockIdx.x + 8 - xoff) & 7), j0 = (int)(blockIdx.x >> 3), slots = (int)(gridDim.x >> 3);
  for (int p = x; p < npatch; p += 8) {
    const int pr = p / npc, pc = p % npc;
    for (int j = j0; j < 64; j += slots) {
      const int mt = pr * PR + j / PC, nt = pc * PC + j % PC;
      gemm_tile256<EPI>(A, lda, Bt, ldb, K, mt * 256, nt * 128, C, ldc, Xres, smem, ln);
    }
  }
}

DI void ln_phase(float* __restrict__ Y, u16* __restrict__ Xb, const float* __restrict__ g, const float* __restrict__ bta, bool write_f32) {
  const int tid = otid(); const int lane = tid & 63, wave = tid >> 6;
  for (int row = blockIdx.x * 4 + wave; row < NT; row += gridDim.x * 4) {
    float* yr = Y + (size_t)row * DM;
    float4 v[4];
#pragma unroll
    for (int i = 0; i < 4; ++i) v[i] = *(const float4*)(yr + (i * 64 + lane) * 4);
    float s = 0.f;
#pragma unroll
    for (int i = 0; i < 4; ++i) s += v[i].x + v[i].y + v[i].z + v[i].w;
    s = wave_sum(s);
    const float mu = s * (1.f / DM);
    float q = 0.f;
#pragma unroll
    for (int i = 0; i < 4; ++i) { float a = v[i].x - mu, b = v[i].y - mu, c = v[i].z - mu, d = v[i].w - mu; q += a * a + b * b + c * c + d * d; }
    q = wave_sum(q);
    const float rstd = rsqrtf(q * (1.f / DM) + 1e-5f);
#pragma unroll
    for (int i = 0; i < 4; ++i) {
      const int c = (i * 64 + lane) * 4;
      float4 gg = *(const float4*)(g + c), bb = *(const float4*)(bta + c), o;
      o.x = (v[i].x - mu) * rstd * gg.x + bb.x; o.y = (v[i].y - mu) * rstd * gg.y + bb.y;
      o.z = (v[i].z - mu) * rstd * gg.z + bb.z; o.w = (v[i].w - mu) * rstd * gg.w + bb.w;
      if (write_f32) *(float4*)(yr + c) = o;
      uint2 ob; ob.x = pack2(o.x, o.y); ob.y = pack2(o.z, o.w);
      *(uint2*)(Xb + (size_t)row * DM + c) = ob;
    }
  }
}

DI void stage_bias(float* tab, const float* rel, int col) {
  for (int d = threadIdx.x; d < 132; d += NTHREADS) tab[d] = rel[BUCKET_LUT[d < 128 ? d : 128] * 16 + col] * LOG2E;
}
DI float bias_at(const float* tab, int dist) { int d = dist < 0 ? 0 : (dist > 128 ? 128 : dist); return tab[d]; }

DI void store_ot(u16* Ob, size_t tok0, int colbase, const f32x16 O[2], int lane, uchar* smem) {
  const int h = lane >> 5, r31 = lane & 31;
  uchar* stg = smem + 57344 + (otid() >> 6) * 4608;
#pragma unroll
  for (int dt = 0; dt < 2; ++dt)
#pragma unroll
    for (int g = 0; g < 4; ++g) {
      uint2 o; o.x = pack2(O[dt][4 * g], O[dt][4 * g + 1]); o.y = pack2(O[dt][4 * g + 2], O[dt][4 * g + 3]);
      *(uint2*)(stg + r31 * 144 + (32 * dt + 8 * g + 4 * h) * 2) = o;
    }
  asm volatile("s_waitcnt lgkmcnt(0)" ::: "memory");
#pragma unroll
  for (int i = 0; i < 4; ++i) {
    const int id = lane + 64 * i, row = (id >> 2) & 31, c = ((id >> 7) << 2) | (id & 3);
    const uint4 v = *(const uint4*)(stg + row * 144 + c * 16);
    *(uint4*)(Ob + kblk(NT, tok0 + row, colbase + c * 8)) = v;
  }
  asm volatile("s_waitcnt lgkmcnt(0)" ::: "memory");
}


#define KV_DECL uint4 pk0_, pk1_, pv0_, pv1_; const int kvr_ = tid >> 3, kvc_ = tid & 7
#define KV_LOAD(kp, vp, stride) do { const u16* kp_ = (kp) + (size_t)kvr_ * (stride) + kvc_ * 8; const u16* vp_ = (vp) + (size_t)kvr_ * (stride) + kvc_ * 8; \
    pk0_ = *(const uint4*)kp_; pk1_ = *(const uint4*)(kp_ + (size_t)32 * (stride)); pv0_ = *(const uint4*)vp_; pv1_ = *(const uint4*)(vp_ + (size_t)32 * (stride)); } while (0)
#define KV_STORE() do { uchar* d_ = Ks + kvr_ * 144 + kvc_ * 16; *(uint4*)d_ = pk0_; *(uint4*)(d_ + 32 * 144) = pk1_; \
    uchar* e_ = Vs + kvr_ * 144 + kvc_ * 16; *(uint4*)e_ = pv0_; *(uint4*)(e_ + 32 * 144) = pv1_; } while (0)

DI void diff_item(const Params& P0_, int l, int b, int item, uchar* smem) {
  const KP P = kparams();
  const u16* H = (const u16*)(P.ws() + OFF_H);
  u16* Ob = (u16*)(P.ws() + OFF_O);
  const int tid = otid(), lane = tid & 63, wave = tid >> 6, h = lane >> 5, r31 = lane & 31;
  const int qb = 31 - (item >> 2), hd = item & 3;
  const int q0 = qb * 128, qw0 = q0 + 32 * wave, qpos = qw0 + r31;
  uchar* Ks = smem; uchar* Vs = smem + 9216; float* tab = (float*)(smem + 18432);
  __syncthreads();
  stage_bias(tab, P.in(2), 12 + hd);
  float d1 = (lane < 32) ? P.in(11)[l * 32 + r31] * P.in(12)[l * 32 + r31] : 0.f;
  float d2 = (lane < 32) ? P.in(13)[l * 32 + r31] * P.in(14)[l * 32 + r31] : 0.f;
  d1 = wave_sum(d1); d2 = wave_sum(d2);
  const float lam_init = 0.8f - 0.6f * expf(-0.3f * (float)l);
  const float lam = expf(d1) - expf(d2) + lam_init;
  const size_t tokbase = (size_t)b * SL;
  bf16x8 qf[4];
  { const u16* qrow = H + (tokbase + qpos) * HC + D_Q + hd * 64;
#pragma unroll
    for (int s = 0; s < 4; ++s) qf[s] = *(const bf16x8*)(qrow + 16 * s + 8 * h); }
  f32x16 O0[2], O1[2];
  O0[0] = zero16(); O0[1] = zero16(); O1[0] = zero16(); O1[1] = zero16();
  float m0 = -1e30f, l0 = 0.f, m1 = -1e30f, l1 = 0.f;
  const float c2 = 0.17677669529663687f * LOG2E;
  const int nt = (q0 + 127) / 64 + 1;
  KV_DECL;
  KV_LOAD(H + tokbase * HC + D_K + hd * 64, H + tokbase * HC + D_V + hd * 64, HC);
  for (int t = 0; t < nt; ++t) {
    const int k0 = t * 64;
    __syncthreads();
    KV_STORE();
    __syncthreads();
    if (t + 1 < nt) KV_LOAD(H + (tokbase + k0 + 64) * HC + D_K + hd * 64, H + (tokbase + k0 + 64) * HC + D_V + hd * 64, HC);
    if (k0 <= qw0 + 31) {
      f32x16 st[2]; bf16x8 pf[4];
      const bool far = (qw0 - (k0 + 63)) >= 128;
      const float bfar = tab[128];
      qk_tile(st, qf, 0, 2, Ks, r31, h);
      if (far) {
        softmax_far<2>(st, c2, bfar, m0, l0, O0, pf);
      } else {
#pragma unroll
        for (int kt = 0; kt < 2; ++kt)
#pragma unroll
          for (int i = 0; i < 16; ++i) { int dist = qpos - (k0 + 32 * kt + crow(i, h)); st[kt][i] = dist >= 0 ? st[kt][i] * c2 + bias_at(tab, dist) : -INFINITY; }
        softmax_step<2>(st, m0, l0, O0, pf);
      }
      pv_tile(O0, pf, Vs, lane);
      qk_tile(st, qf, 2, 2, Ks, r31, h);
      if (far) {
        softmax_far<2>(st, c2, bfar, m1, l1, O1, pf);
      } else {
#pragma unroll
        for (int kt = 0; kt < 2; ++kt)
#pragma unroll
          for (int i = 0; i < 16; ++i) { int dist = qpos - (k0 + 32 * kt + crow(i, h)); st[kt][i] = dist >= 0 ? st[kt][i] * c2 + bias_at(tab, dist) : -INFINITY; }
        softmax_step<2>(st, m1, l1, O1, pf);
      }
      pv_tile(O1, pf, Vs, lane);
    }
  }
  l0 += __shfl_xor(l0, 32, 64); l1 += __shfl_xor(l1, 32, 64);
  const float i0 = 1.f / l0, i1 = lam / l1;
  float ss = 0.f;
#pragma unroll
  for (int dt = 0; dt < 2; ++dt)
#pragma unroll
    for (int i = 0; i < 16; ++i) { float v = O0[dt][i] * i0 - O1[dt][i] * i1; O0[dt][i] = v; ss += v * v; }
  ss += __shfl_xor(ss, 32, 64);
  const float rn = rsqrtf(ss * (1.f / 64.f) + 1e-6f) * (1.f - lam_init);
  const float* gp = P.in(15) + l * 64;
#pragma unroll
  for (int dt = 0; dt < 2; ++dt)
#pragma unroll
    for (int i = 0; i < 16; ++i) O0[dt][i] = O0[dt][i] * rn * gp[32 * dt + crow(i, h)];
  store_ot(Ob, tokbase + qw0, 768 + hd * 64, O0, lane, smem);
}

DI void moba_item(const Params& P0_, int b, int item, uchar* smem) {
  const KP P = kparams();
  const u16* H = (const u16*)(P.ws() + OFF_H);
  u16* Ob = (u16*)(P.ws() + OFF_O);
  const float* KM = (const float*)(P.ws() + OFF_KM);
  const int tid = otid(), lane = tid & 63, wave = tid >> 6, h = lane >> 5, r31 = lane & 31;
  const int qb = 31 - (item >> 2), hd = item & 3;
  const int q0 = qb * 128, qw0 = q0 + 32 * wave, qpos = qw0 + r31, cur = q0 >> 8;
  uchar* Ks = smem; uchar* Vs = smem + 9216; float* tab = (float*)(smem + 18432);
  float* kms = (float*)(smem + 18432 + 1024);
  unsigned* need = (unsigned*)(smem + 18432 + 1024 + 4096);
  __syncthreads();
  stage_bias(tab, P.in(2), 8 + hd);
  for (int i = tid; i < 16 * 64; i += NTHREADS) kms[i] = KM[((size_t)b * 16 + (i >> 6)) * 256 + hd * 64 + (i & 63)];
  if (tid == 0) *need = 0u;
  const size_t tokbase = (size_t)b * SL;
  bf16x8 qf[4];
  { const u16* qrow = H + (tokbase + qpos) * HC + C_Q + hd * 64;
#pragma unroll
    for (int s = 0; s < 4; ++s) qf[s] = *(const bf16x8*)(qrow + 16 * s + 8 * h); }
  __syncthreads();
  unsigned qmask = 0u;
  {
    float gate[16];
#pragma unroll
    for (int n = 0; n < 16; ++n) {
      float a = 0.f;
      if (n < cur) {
#pragma unroll
        for (int s = 0; s < 4; ++s)
#pragma unroll
          for (int j = 0; j < 8; ++j) a += bf2f((u16)qf[s][j]) * kms[n * 64 + 16 * s + 8 * h + j];
      }
      a += __shfl_xor(a, 32, 64);
      gate[n] = a;
    }
#pragma unroll
    for (int r = 0; r < 3; ++r) {
      float best = -INFINITY; int bi = -1;
#pragma unroll
      for (int n = 0; n < 16; ++n) if (n < cur && !((qmask >> n) & 1u) && gate[n] > best) { best = gate[n]; bi = n; }
      if (bi >= 0) qmask |= 1u << bi;
    }
    qmask |= 1u << cur;
  }
  unsigned wneed = 0u;
#pragma unroll
  for (int n = 0; n < 16; ++n) if (__builtin_amdgcn_ballot_w64((qmask >> n) & 1u) != 0ull) wneed |= 1u << n;
  if (lane == 0) atomicOr(need, wneed);
  __syncthreads();
  const unsigned bneed = *need;
  f32x16 O[2]; O[0] = zero16(); O[1] = zero16();
  float m = -1e30f, ls = 0.f;
  const float c2 = 0.125f * LOG2E;
  const int nt = (q0 + 127) / 64 + 1;
  KV_DECL;
  int t = 0;
  while (t < nt && !((bneed >> (t >> 2)) & 1u)) ++t;
  if (t < nt) KV_LOAD(H + (tokbase + t * 64) * HC + C_K + hd * 64, H + (tokbase + t * 64) * HC + C_V + hd * 64, HC);
  while (t < nt) {
    const int k0 = t * 64, jb = t >> 2;
    __syncthreads();
    KV_STORE();
    __syncthreads();
    int tn = t + 1;
    while (tn < nt && !((bneed >> (tn >> 2)) & 1u)) ++tn;
    if (tn < nt) KV_LOAD(H + (tokbase + tn * 64) * HC + C_K + hd * 64, H + (tokbase + tn * 64) * HC + C_V + hd * 64, HC);
    t = tn;
    if (((wneed >> jb) & 1u) && k0 <= qw0 + 31) {
      f32x16 st[2]; bf16x8 pf[4];
      qk_tile(st, qf, 0, 4, Ks, r31, h);
      const bool selq = (qmask >> jb) & 1u;
      if ((qw0 - (k0 + 63)) >= 128) {
        softmax_far<2>(st, c2, selq ? tab[128] : -INFINITY, m, ls, O, pf);
      } else {
#pragma unroll
        for (int kt = 0; kt < 2; ++kt)
#pragma unroll
          for (int i = 0; i < 16; ++i) {
            int dist = qpos - (k0 + 32 * kt + crow(i, h));
            st[kt][i] = (selq && dist >= 0) ? st[kt][i] * c2 + bias_at(tab, dist) : -INFINITY;
          }
        softmax_step<2>(st, m, ls, O, pf);
      }
      pv_tile(O, pf, Vs, lane);
    }
  }
  ls += __shfl_xor(ls, 32, 64);
  const float inv = ls > 0.f ? 1.f / ls : 0.f;
#pragma unroll
  for (int dt = 0; dt < 2; ++dt)
#pragma unroll
    for (int i = 0; i < 16; ++i) O[dt][i] *= inv;
  store_ot(Ob, tokbase + qw0, 512 + hd * 64, O, lane, smem);
}

DI void nsa_item(const Params& P0_, int b, int item, uchar* smem) {
  const KP P = kparams();
  const u16* H = (const u16*)(P.ws() + OFF_H);
  u16* Ob = (u16*)(P.ws() + OFF_O);
  const u16* KC = (const u16*)(P.ws() + OFF_KC);
  const u16* VC = (const u16*)(P.ws() + OFF_VC);
  const int tid = otid(), lane = tid & 63, wave = tid >> 6, h = lane >> 5, r31 = lane & 31;
  const int qb = 127 - item;
  const int q0 = qb * 32, qpos = q0 + r31, cur = q0 >> 6;
  uchar* Ks = smem; uchar* Vs = smem + 9216;
  float* tabs = (float*)(smem + 18432);
  float* imp = (float*)(smem + 18432 + 2112);
  unsigned* selm = (unsigned*)(smem + 18432 + 2112 + 32768);
  __syncthreads();
  for (int i = tid; i < 4 * 132; i += NTHREADS) { int w = i / 132, d = i % 132; tabs[i] = P.in(2)[BUCKET_LUT[d < 128 ? d : 128] * 16 + 4 + w] * LOG2E; }
  if (tid < 64) selm[tid] = 0u;
  const float* tab = tabs + wave * 132;
  const size_t tokbase = (size_t)b * SL;
  bf16x8 qf[4];
  { const u16* qrow = H + (tokbase + qpos) * HC + B_Q + wave * 64;
#pragma unroll
    for (int s = 0; s < 4; ++s) qf[s] = *(const bf16x8*)(qrow + 16 * s + 8 * h); }
  const float c2 = 0.125f * LOG2E;
  f32x16 acc[2];
  const u16* gp = H + (tokbase + qpos) * HC + B_G + wave * 3;
  {
    f32x16 O[4]; O[0] = zero16(); O[1] = zero16(); O[2] = zero16(); O[3] = zero16();
    float m = -1e30f, ls = 0.f;
    const int nmax = q0 / 16;
    const int ntl = (q0 >= 0 ? nmax / 64 + 1 : 0);
    for (int t = 0; t < ntl; ++t) {
      const int n0 = t * 64;
      __syncthreads();
      stage64(Ks, KC + ((size_t)b * 256 + n0) * 64, 64);
      stage64(Vs, VC + ((size_t)b * 256 + n0) * 64, 64);
      __syncthreads();
      f32x16 st[2]; bf16x8 pf[4];
      qk_tile(st, qf, 0, 4, Ks, r31, h);
#pragma unroll
      for (int kt = 0; kt < 2; ++kt)
#pragma unroll
        for (int i = 0; i < 16; ++i) {
          int n = n0 + 32 * kt + crow(i, h);
          st[kt][i] = (16 * n + 31 <= qpos) ? st[kt][i] * c2 : -INFINITY;
        }
      softmax_step<4, false>(st, m, ls, O, pf);
      pv_tile(O, pf, Vs, lane);
#pragma unroll
      for (int sp = 0; sp < 4; ++sp) {
#pragma unroll
        for (int u = 0; u < 2; ++u) {
          const int j = 32 * u + r31;
          bf16x8 of;
#pragma unroll
          for (int jj = 0; jj < 8; ++jj) {
            int n = n0 + 16 * sp + 8 * (jj >> 2) + 4 * h + (jj & 3);
            of[jj] = (n >= 4 * j - 1 && n <= 4 * j + 3) ? (short)0x3F80 : (short)0;
          }
          O[2 + u] = mfma32(of, pf[sp], O[2 + u]);
        }
      }
    }
    ls += __shfl_xor(ls, 32, 64);
    const float inv = ls > 0.f ? 1.f / ls : 0.f;
    const float ginv = inv / (1.f + __expf(-bf2f(gp[0])));
#pragma unroll
    for (int dt = 0; dt < 2; ++dt)
#pragma unroll
      for (int i = 0; i < 16; ++i) acc[dt][i] = ginv * O[dt][i];
#pragma unroll
    for (int u = 0; u < 2; ++u)
#pragma unroll
      for (int i = 0; i < 16; ++i) imp[(wave * 32 + r31) * 64 + 32 * u + crow(i, h)] = O[2 + u][i] * inv;
  }
  __syncthreads();
  {
    const int q = tid >> 3, jp = tid & 7, qp = q0 + q;
    float* row = imp + q * 64;
    float sv[8];
#pragma unroll
    for (int k = 0; k < 8; ++k) { int j = jp * 8 + k; sv[k] = imp[(0 * 32 + q) * 64 + j] + imp[(1 * 32 + q) * 64 + j] + imp[(2 * 32 + q) * 64 + j] + imp[(3 * 32 + q) * 64 + j]; }
    __syncthreads();
#pragma unroll
    for (int k = 0; k < 8; ++k) {
      int j = jp * 8 + k; float v = sv[k];
      if (j == 0 || j == cur || j == cur - 1) v = INFINITY;
      if (j * 64 > qp) v = -INFINITY;
      row[j] = v;
    }
    __syncthreads();
    unsigned bits = 0u;
#pragma unroll
    for (int k = 0; k < 8; ++k) {
      int j = jp * 8 + k; float v = row[j];
      int rank = 0;
      for (int j2 = 0; j2 < 64; ++j2) { float v2 = row[j2]; rank += (v2 > v || (v2 == v && j2 < j)) ? 1 : 0; }
      if (rank < 16 && j <= cur) bits |= 1u << k;
    }
    if (bits) atomicOr(&selm[q * 2 + (jp >> 2)], bits << ((jp & 3) * 8));
  }
  __syncthreads();
  const unsigned my_lo = selm[r31 * 2], my_hi = selm[r31 * 2 + 1];
  unsigned un_lo = 0u, un_hi = 0u;
  for (int q = 0; q < 32; ++q) { un_lo |= selm[q * 2]; un_hi |= selm[q * 2 + 1]; }
  KV_DECL;
  {
    f32x16 O[2]; O[0] = zero16v(); O[1] = zero16v();
    float m = -1e30f, ls = 0.f;
    const unsigned long long un = ((unsigned long long)un_hi << 32) | un_lo;
    int j = 0;
    while (j <= cur && !((un >> j) & 1ull)) ++j;
    if (j <= cur) KV_LOAD(H + (tokbase + j * 64) * HC + B_KS, H + (tokbase + j * 64) * HC + B_VS, HC);
    for (; j <= cur;) {
      const int k0 = j * 64;
      __syncthreads();
      KV_STORE();
      __syncthreads();
      int jn = j + 1;
      while (jn <= cur && !((un >> jn) & 1ull)) ++jn;
      if (jn <= cur) KV_LOAD(H + (tokbase + jn * 64) * HC + B_KS, H + (tokbase + jn * 64) * HC + B_VS, HC);
      const int jc = j; j = jn;
      const bool selq = jc < 32 ? ((my_lo >> jc) & 1u) : ((my_hi >> (jc - 32)) & 1u);
      f32x16 st[2]; bf16x8 pf[4];
      qk_tile(st, qf, 0, 4, Ks, r31, h);
      if ((q0 - (k0 + 63)) >= 128) {
        softmax_far<2, false>(st, c2, selq ? tab[128] : -INFINITY, m, ls, O, pf);
      } else {
#pragma unroll
        for (int kt = 0; kt < 2; ++kt)
#pragma unroll
          for (int i = 0; i < 16; ++i) {
            int dist = qpos - (k0 + 32 * kt + crow(i, h));
            st[kt][i] = (selq && dist >= 0) ? st[kt][i] * c2 + bias_at(tab, dist) : -INFINITY;
          }
        softmax_step<2, false>(st, m, ls, O, pf);
      }
      pv_tile(O, pf, Vs, lane);
    }
    ls += __shfl_xor(ls, 32, 64);
    const float inv = ls > 0.f ? 1.f / ls : 0.f;
    const float ginv = inv / (1.f + __expf(-bf2f(gp[1])));
#pragma unroll
    for (int dt = 0; dt < 2; ++dt)
#pragma unroll
      for (int i = 0; i < 16; ++i) acc[dt][i] += ginv * O[dt][i];
  }
  {
    f32x16 O[2]; O[0] = zero16v(); O[1] = zero16v();
    float m = -1e30f, ls = 0.f;
    int tlo = q0 - 511; tlo = tlo < 0 ? 0 : tlo >> 6;
    KV_LOAD(H + (tokbase + tlo * 64) * HC + B_KW, H + (tokbase + tlo * 64) * HC + B_VW, HC);
    for (int t = tlo; t <= cur; ++t) {
      const int k0 = t * 64;
      __syncthreads();
      KV_STORE();
      __syncthreads();
      if (t < cur) KV_LOAD(H + (tokbase + k0 + 64) * HC + B_KW, H + (tokbase + k0 + 64) * HC + B_VW, HC);
      f32x16 st[2]; bf16x8 pf[4];
      qk_tile(st, qf, 0, 4, Ks, r31, h);
      if ((q0 - (k0 + 63)) >= 128 && (q0 + 31 - k0) < 512) {
        softmax_far<2, false>(st, c2, tab[128], m, ls, O, pf);
      } else {
#pragma unroll
        for (int kt = 0; kt < 2; ++kt)
#pragma unroll
          for (int i = 0; i < 16; ++i) {
            int dist = qpos - (k0 + 32 * kt + crow(i, h));
            st[kt][i] = (dist >= 0 && dist < 512) ? st[kt][i] * c2 + bias_at(tab, dist) : -INFINITY;
          }
        softmax_step<2, false>(st, m, ls, O, pf);
      }
      pv_tile(O, pf, Vs, lane);
    }
    ls += __shfl_xor(ls, 32, 64);
    const float inv = ls > 0.f ? 1.f / ls : 0.f;
    const float ginv2 = inv / (1.f + __expf(-bf2f(gp[2])));
#pragma unroll
    for (int dt = 0; dt < 2; ++dt)
#pragma unroll
      for (int i = 0; i < 16; ++i) acc[dt][i] += ginv2 * O[dt][i];
  }
  store_ot(Ob, tokbase + q0, 256 + wave * 64, acc, lane, smem);
}

DI float gelu_tanh(float x) { float u = 0.7978845608028654f * (x + 0.044715f * x * x * x); return 0.5f * x * (1.f + tanhf(u)); }
DI void compress_item(const Params& P0_, int l, int item, uchar* smem) {
  const KP P = kparams();
  const u16* H = (const u16*)(P.ws() + OFF_H);
  const int tid = otid();
  const int which = item & 1, rest = item >> 1, b = rest & 7, grp = rest >> 3;
  const int nb = grp * 5;
  float* A = (float*)smem;
  float* part = (float*)(smem + 40960);
  float* gl = (float*)(smem + 40960 + 5120);
  const float* pos = P.in(which ? 6 : 5) + (size_t)l * 2048;
  const float* w1 = P.in(which ? 9 : 7) + (size_t)l * 2048 * 64;
  const float* w2 = P.in(which ? 10 : 8) + (size_t)l * 64 * 64;
  const int col = which ? B_VC : B_KC;
  __syncthreads();
  for (int e = tid; e < 5 * 2048; e += NTHREADS) {
    int r = e >> 11, k = e & 2047, t = k >> 6, d = k & 63;
    int tok = 16 * (nb + r) + t;
    A[e] = bf2f(H[((size_t)b * SL + tok) * HC + col + d]) + pos[k];
  }
  __syncthreads();
  const int j = tid & 63, pt = tid >> 6;
  float a[5] = {0.f, 0.f, 0.f, 0.f, 0.f};
  for (int k = pt * 512; k < pt * 512 + 512; ++k) {
    float wv = w1[(size_t)k * 64 + j];
#pragma unroll
    for (int r = 0; r < 5; ++r) a[r] += A[r * 2048 + k] * wv;
  }
#pragma unroll
  for (int r = 0; r < 5; ++r) part[(pt * 5 + r) * 64 + j] = a[r];
  __syncthreads();
  for (int e = tid; e < 320; e += NTHREADS) {
    int r = e >> 6, jj = e & 63;
    float s = part[(0 * 5 + r) * 64 + jj] + part[(1 * 5 + r) * 64 + jj] + part[(2 * 5 + r) * 64 + jj] + part[(3 * 5 + r) * 64 + jj];
    gl[r * 64 + jj] = gelu_tanh(s);
  }
  __syncthreads();
  u16* dst = (u16*)(P.ws() + (which ? OFF_VC : OFF_KC));
  for (int e = tid; e < 320; e += NTHREADS) {
    int r = e >> 6, jj = e & 63;
    float s = 0.f;
    for (int i = 0; i < 64; ++i) s += gl[r * 64 + i] * w2[i * 64 + jj];
    dst[((size_t)b * 256 + nb + r) * 64 + jj] = f2bf(s);
  }
  if (grp == 50) { for (int e = tid; e < 64; e += NTHREADS) dst[((size_t)b * 256 + 255) * 64 + e] = 0; }
}
DI void kmean_item(const Params& P0_, int item, uchar* smem) {
  const KP P = kparams();
  const u16* H = (const u16*)(P.ws() + OFF_H);
  float* KM = (float*)(P.ws() + OFF_KM);
  const int tid = otid(), lane = tid & 63, wave = tid >> 6;
  const int b = item >> 4, blk = item & 15;
  float* part = (float*)smem;
  float a0 = 0.f, a1 = 0.f, a2 = 0.f, a3 = 0.f;
  const u16* p = H + ((size_t)b * SL + blk * 256 + wave * 64) * HC + C_K + lane * 4;
#pragma unroll 16
  for (int t = 0; t < 64; ++t) {
    uint2 v = *(const uint2*)(p + (size_t)t * HC);
    a0 += bflo(v.x); a1 += bfhi(v.x); a2 += bflo(v.y); a3 += bfhi(v.y);
  }
  __syncthreads();
  part[wave * 256 + lane * 4 + 0] = a0; part[wave * 256 + lane * 4 + 1] = a1; part[wave * 256 + lane * 4 + 2] = a2; part[wave * 256 + lane * 4 + 3] = a3;
  __syncthreads();
  KM[((size_t)b * 16 + blk) * 256 + tid] = (part[tid] + part[256 + tid] + part[512 + tid] + part[768 + tid]) * (1.f / 256.f);
}

DI unsigned sortable(float f) { unsigned u = __float_as_uint(f); return (u & 0x80000000u) ? ~u : (u | 0x80000000u); }
DI void dsa_item(const Params& P0_, int b, int item, uchar* smem) {
  const KP P = kparams();
  const u16* H = (const u16*)(P.ws() + OFF_H);
  u16* Ob = (u16*)(P.ws() + OFF_O);
  const int tid = otid(), lane = tid & 63, wave = tid >> 6, h = lane >> 5, r31 = lane & 31;
  const int qb = 1023 - item;
  const int q0 = qb * 4;
  const size_t tokbase = (size_t)b * SL;
  float* sc = (float*)smem;
  u16* sel = (u16*)(smem + 65536);
  float* tabs = (float*)(smem + 65536 + 2048);
  __syncthreads();
  {
    const int hidx = (r31 & 3) | (((r31 >> 3) & 1) << 2), ql = ((r31 >> 2) & 1) | (((r31 >> 4) & 1) << 1);
    bf16x8 af[4];
    const u16* arow = H + (tokbase + q0 + ql) * HC + A_QI + hidx * 64;
#pragma unroll
    for (int s = 0; s < 4; ++s) af[s] = *(const bf16x8*)(arow + 16 * s + 8 * h);
    float wa[8], wb[8];
    { const uint4 va = *(const uint4*)(H + (tokbase + q0 + h) * HC + A_W), vb = *(const uint4*)(H + (tokbase + q0 + h + 2) * HC + A_W);
      wa[0] = bflo(va.x); wa[1] = bfhi(va.x); wa[2] = bflo(va.y); wa[3] = bfhi(va.y); wa[4] = bflo(va.z); wa[5] = bfhi(va.z); wa[6] = bflo(va.w); wa[7] = bfhi(va.w);
      wb[0] = bflo(vb.x); wb[1] = bfhi(vb.x); wb[2] = bflo(vb.y); wb[3] = bfhi(vb.y); wb[4] = bflo(vb.z); wb[5] = bfhi(vb.z); wb[6] = bflo(vb.w); wb[7] = bfhi(vb.w); }
    const int nkt = (q0 + 3) / 32 + 1;
    const u16* KIF = (const u16*)(P.ws() + OFF_KIF);
    bf16x8 k0f, k1f, k2f, k3f;
    {
      const int c0 = wave < nkt ? wave : 0;
      const u16* krow = KIF + ((size_t)((tokbase >> 5) + c0) * 256 + lane) * 8;
      k0f = *(const bf16x8*)(krow); k1f = *(const bf16x8*)(krow + 512); k2f = *(const bf16x8*)(krow + 1024); k3f = *(const bf16x8*)(krow + 1536);
    }
    for (int c = wave; c < nkt; c += 4) {
      bf16x8 n0f = k0f, n1f = k1f, n2f = k2f, n3f = k3f;
      if (c + 4 < nkt) {
        const u16* krow = KIF + ((size_t)((tokbase >> 5) + c + 4) * 256 + lane) * 8;
        n0f = *(const bf16x8*)(krow); n1f = *(const bf16x8*)(krow + 512); n2f = *(const bf16x8*)(krow + 1024); n3f = *(const bf16x8*)(krow + 1536);
      }
      f32x16 a = zero16();
      a = mfma32(af[0], k0f, a); a = mfma32(af[1], k1f, a); a = mfma32(af[2], k2f, a); a = mfma32(af[3], k3f, a);
      float sa = 0.f, sb = 0.f;
#pragma unroll
      for (int i = 0; i < 8; ++i) { sa += fmaxf(a[i], 0.f) * wa[i]; sb += fmaxf(a[8 + i], 0.f) * wb[i]; }
      sc[h * 4096 + 32 * c + r31] = sa;
      sc[(h + 2) * 4096 + 32 * c + r31] = sb;
      k0f = n0f; k1f = n1f; k2f = n2f; k3f = n3f;
    }
  }
  __syncthreads();
  const int qpos = q0 + wave, nvalid = qpos + 1;
  int count;
  unsigned long long myw = 0ull;
  if (nvalid <= 256) {
    count = nvalid;
    const int rem = nvalid - 64 * lane;
    myw = rem >= 64 ? ~0ull : (rem <= 0 ? 0ull : ((1ull << rem) - 1ull));
  } else {
    unsigned u[64];
#pragma unroll
    for (int c = 0; c < 64; ++c) { int s = lane + 64 * c; u[c] = (s < nvalid) ? sortable(sc[wave * 4096 + s]) : 0u; }
    const int ng = (nvalid + 1023) >> 10;
    unsigned T = 0u;
    bool exact = false;
    for (int bit = 31; bit >= 0; --bit) {
      const unsigned cand = T | (1u << bit);
      int lc = 0;
#pragma unroll
      for (int g = 0; g < 4; ++g) {
        if (g < ng) {
#pragma unroll
          for (int c = 16 * g; c < 16 * g + 16; ++c) lc += (u[c] >= cand) ? 1 : 0;
        }
      }
      const int cnt = wave_sum_i(lc);
      if (cnt >= 256) T = cand;
      if (cnt == 256) { exact = true; break; }
    }
    if (exact) {
#pragma unroll
      for (int g = 0; g < 4; ++g) {
        if (g < ng) {
#pragma unroll
          for (int c = 16 * g; c < 16 * g + 16; ++c) { const unsigned long long bt = __builtin_amdgcn_ballot_w64(u[c] >= T); if (lane == c) myw = bt; }
        }
      }
    } else {
      int cgt = 0;
#pragma unroll
      for (int c = 0; c < 64; ++c) cgt += __builtin_popcountll(__builtin_amdgcn_ballot_w64(u[c] > T));
      const int need_eq = 256 - cgt;
      int eq_seen = 0;
#pragma unroll
      for (int c = 0; c < 64; ++c) {
        const bool gt = u[c] > T, eq = u[c] == T;
        const unsigned long long beq = __builtin_amdgcn_ballot_w64(eq);
        const int erank = eq_seen + (int)__builtin_amdgcn_mbcnt_hi((unsigned)(beq >> 32), __builtin_amdgcn_mbcnt_lo((unsigned)beq, 0u));
        const bool take = gt || (eq && erank < need_eq);
        const unsigned long long bt = __builtin_amdgcn_ballot_w64(take);
        if (lane == c) myw = bt;
        eq_seen += __builtin_popcountll(beq);
      }
    }
    count = 256;
  }
  (void)count;
  ((unsigned long long*)(P.ws() + OFF_SEL))[(tokbase + qpos) * 64 + lane] = myw;
}

DI void dsa_dense_item(const Params& P0_, int b, int item, uchar* smem) {
  const KP P = kparams();
  const u16* H = (const u16*)(P.ws() + OFF_H);
  u16* Ob = (u16*)(P.ws() + OFF_O);
  const int tid = otid(), lane = tid & 63, wave = tid >> 6, h = lane >> 5, r31 = lane & 31;
  const int qb = 31 - (item >> 2), hd = item & 3;
  const int q0 = qb * 128, qw0 = q0 + 32 * wave, qpos = qw0 + r31;
  uchar* Ks = smem; uchar* Vs = smem + 9216; float* tab = (float*)(smem + 18432);
  __syncthreads();
  stage_bias(tab, P.in(2), hd);
  const size_t tokbase = (size_t)b * SL;
  bf16x8 qf[4];
  { const u16* qrow = H + (tokbase + qpos) * HC + A_Q + hd * 64;
#pragma unroll
    for (int s = 0; s < 4; ++s) qf[s] = *(const bf16x8*)(qrow + 16 * s + 8 * h); }
  const unsigned long long* mrow = (const unsigned long long*)(P.ws() + OFF_SEL) + (tokbase + qpos) * 64;
  f32x16 O[2]; O[0] = zero16(); O[1] = zero16();
  float m = -1e30f, ls = 0.f;
  const float c2 = 0.125f * LOG2E;
  const int nt = (q0 + 127) / 64 + 1;
  KV_DECL;
  KV_LOAD(H + tokbase * HC + A_K + hd * 64, H + tokbase * HC + A_V + hd * 64, HC);
  unsigned long long mw = mrow[0];
  for (int t = 0; t < nt; ++t) {
    const int k0 = t * 64;
    __syncthreads();
    KV_STORE();
    __syncthreads();
    const unsigned long long mcur = mw;
    if (t + 1 < nt) { KV_LOAD(H + (tokbase + k0 + 64) * HC + A_K + hd * 64, H + (tokbase + k0 + 64) * HC + A_V + hd * 64, HC); mw = mrow[t + 1]; }
    if (k0 <= qw0 + 31) {
      f32x16 st[2]; bf16x8 pf[4];
      qk_tile(st, qf, 0, 4, Ks, r31, h);
      const unsigned mlo = (unsigned)mcur, mhi = (unsigned)(mcur >> 32);
      if ((qw0 - (k0 + 63)) >= 128) {
        const float bfar = tab[128];
#pragma unroll
        for (int kt = 0; kt < 2; ++kt)
#pragma unroll
          for (int i = 0; i < 16; ++i) {
            const unsigned mm = kt ? mhi : mlo;
            st[kt][i] = ((mm >> crow(i, h)) & 1u) ? st[kt][i] * c2 + bfar : -INFINITY;
          }
      } else {
#pragma unroll
        for (int kt = 0; kt < 2; ++kt)
#pragma unroll
          for (int i = 0; i < 16; ++i) {
            const unsigned mm = kt ? mhi : mlo;
            const int dist = qpos - (k0 + 32 * kt + crow(i, h));
            st[kt][i] = ((mm >> crow(i, h)) & 1u) ? st[kt][i] * c2 + bias_at(tab, dist) : -INFINITY;
          }
      }
      softmax_step<2>(st, m, ls, O, pf);
      pv_tile(O, pf, Vs, lane);
    }
  }
  ls += __shfl_xor(ls, 32, 64);
  const float inv = ls > 0.f ? 1.f / ls : 0.f;
#pragma unroll
  for (int dt = 0; dt < 2; ++dt)
#pragma unroll
    for (int i = 0; i < 16; ++i) O[dt][i] *= inv;
  store_ot(Ob, tokbase + qw0, hd * 64, O, lane, smem);
}

DI void dsa_gather_item(const Params& P0_, int b, int item, uchar* smem) {
  const KP P = kparams();
  const u16* H = (const u16*)(P.ws() + OFF_H);
  u16* Ob = (u16*)(P.ws() + OFF_O);
  const int tid = otid(), lane = tid & 63, wave = tid >> 6, l7 = lane & 7, kg = lane >> 3;
  const int hd = item >> 8, qg = 255 - (item & 255);
  const size_t tokbase = (size_t)b * SL;
  float* tab = (float*)smem;
  u16* selw = (u16*)(smem + 1024 + wave * 2048);
  float* plw = (float*)(smem + 1024 + wave * 2048 + 512);
  u16* pbw = (u16*)(smem + 1024 + wave * 2048 + 1536);
  __syncthreads();
  stage_bias(tab, P.in(2), hd);
  __syncthreads();
  const u16* kb = H + tokbase * HC + A_K + hd * 64 + l7 * 8;
  const u16* vb = H + tokbase * HC + A_V + hd * 64 + l7 * 8;
  for (int qi = 0; qi < 4; ++qi) {
    const int qpos = qg * 16 + wave * 4 + qi;
    const int count = qpos + 1 < 256 ? qpos + 1 : 256;
    {
      const u16* gsel = (const u16*)(P.ws() + OFF_SEL) + (tokbase + qpos) * 256;
      *(uint2*)(selw + lane * 4) = *(const uint2*)(gsel + lane * 4);
    }
    asm volatile("s_waitcnt lgkmcnt(0)" ::: "memory");
    const uint4 qv = *(const uint4*)(H + (tokbase + qpos) * HC + A_Q + hd * 64 + l7 * 8);
#pragma unroll 8
    for (int i = 0; i < 32; ++i) {
      const int kk = 8 * i + kg;
      const int idx = selw[kk];
      const uint4 kv = *(const uint4*)(kb + (size_t)idx * HC);
      float d = dot2bf(kv.x, qv.x, 0.f); d = dot2bf(kv.y, qv.y, d); d = dot2bf(kv.z, qv.z, d); d = dot2bf(kv.w, qv.w, d);
      d = red8(d);
      if (l7 == 0) plw[kk] = d;
    }
    {
      float lg[4];
#pragma unroll
      for (int c = 0; c < 4; ++c) { const int kk = lane + 64 * c; lg[c] = (kk < count) ? plw[kk] * (0.125f * LOG2E) + bias_at(tab, qpos - (int)selw[kk]) : -INFINITY; }
      float mx = fmaxf(fmaxf(lg[0], lg[1]), fmaxf(lg[2], lg[3]));
      mx = wave_max(mx);
      float sm = 0.f;
#pragma unroll
      for (int c = 0; c < 4; ++c) { lg[c] = __builtin_amdgcn_exp2f(lg[c] - mx); sm += lg[c]; }
      sm = wave_sum(sm);
      const float inv = 1.f / sm;
#pragma unroll
      for (int c = 0; c < 4; ++c) pbw[lane + 64 * c] = f2bf(lg[c] * inv);
    }
    asm volatile("s_waitcnt lgkmcnt(0)" ::: "memory");
    float a0 = 0.f, a1 = 0.f, a2 = 0.f, a3 = 0.f, a4 = 0.f, a5 = 0.f, a6 = 0.f, a7 = 0.f;
    const int nb = (count + 15) >> 4;
    const unsigned* sel32 = (const unsigned*)selw;
    const unsigned* pb32 = (const unsigned*)pbw;
#pragma unroll 4
    for (int i = 0; i < nb; ++i) {
      const int kp = 8 * i + kg;
      const unsigned ii = sel32[kp], pp = pb32[kp];
      const uint4 x = *(const uint4*)(vb + (size_t)(ii & 0xffffu) * HC);
      const uint4 y = *(const uint4*)(vb + (size_t)(ii >> 16) * HC);
      a0 = dot2bf(__builtin_amdgcn_perm(y.x, x.x, 0x05040100u), pp, a0); a1 = dot2bf(__builtin_amdgcn_perm(y.x, x.x, 0x07060302u), pp, a1);
      a2 = dot2bf(__builtin_amdgcn_perm(y.y, x.y, 0x05040100u), pp, a2); a3 = dot2bf(__builtin_amdgcn_perm(y.y, x.y, 0x07060302u), pp, a3);
      a4 = dot2bf(__builtin_amdgcn_perm(y.z, x.z, 0x05040100u), pp, a4); a5 = dot2bf(__builtin_amdgcn_perm(y.z, x.z, 0x07060302u), pp, a5);
      a6 = dot2bf(__builtin_amdgcn_perm(y.w, x.w, 0x05040100u), pp, a6); a7 = dot2bf(__builtin_amdgcn_perm(y.w, x.w, 0x07060302u), pp, a7);
    }
#pragma unroll
    for (int o = 8; o < 64; o <<= 1) {
      a0 += __shfl_xor(a0, o, 64); a1 += __shfl_xor(a1, o, 64); a2 += __shfl_xor(a2, o, 64); a3 += __shfl_xor(a3, o, 64);
      a4 += __shfl_xor(a4, o, 64); a5 += __shfl_xor(a5, o, 64); a6 += __shfl_xor(a6, o, 64); a7 += __shfl_xor(a7, o, 64);
    }
    if (kg == 0) {
      uint4 o; o.x = pack2(a0, a1); o.y = pack2(a2, a3); o.z = pack2(a4, a5); o.w = pack2(a6, a7);
      *(uint4*)(Ob + (tokbase + qpos) * DM + hd * 64 + l7 * 8) = o;
    }
  }
}

DI void cross_item(const Params& P0_, int b, int item, uchar* smem) {
  const KP P = kparams();
  const u16* Q = (const u16*)(P.ws() + OFF_H);
  const u16* KV = (const u16*)(P.ws() + OFF_KV);
  u16* Ob = (u16*)(P.ws() + OFF_O);
  const int tid = otid(), lane = tid & 63, wave = tid >> 6, h = lane >> 5, r31 = lane & 31;
  const int hd = (item >> 5) & 3, qb = item & 31;
  const int qpos = qb * 128 + wave * 32 + r31;
  const size_t tok = (size_t)b * SL + qpos;
  uchar* Ks = smem; uchar* Vs = smem + 33792;
  f32x16 O[8];
#pragma unroll
  for (int i = 0; i < 8; ++i) O[i] = zero16();
  float m = -1e30f, ls = 0.f;
  const u16* qrow = Q + ((size_t)(hd * (NT / 32) + ((size_t)b * SL + qb * 128 + wave * 32) / 32) * 16 * 64 + lane) * 8;
  const int blk = (lane >> 4) & 1, q4 = (lane & 15) >> 2, p4 = lane & 3;
  for (int t = 0; t < 4; ++t) {
    __syncthreads();
    for (int i = 0; i < 8; ++i) {
      int c = tid + 256 * i, row = c >> 5, kc = c & 31;
      const u16* src = KV + ((size_t)b * 256 + t * 64 + row) * 2048 + hd * 256 + kc * 8;
      *(uint4*)(Ks + row * 528 + kc * 16) = *(const uint4*)src;
      *(uint4*)(Vs + row * 528 + kc * 16) = *(const uint4*)(src + 1024);
    }
    __syncthreads();
    f32x16 st[2]; st[0] = zero16(); st[1] = zero16();
#pragma unroll 4
    for (int s = 0; s < 16; ++s) {
      bf16x8 qf = *(const bf16x8*)(qrow + s * 512);
#pragma unroll
      for (int kt = 0; kt < 2; ++kt) {
        bf16x8 kf = *(const bf16x8*)(Ks + (32 * kt + r31) * 528 + (2 * s + h) * 16);
        st[kt] = mfma32(kf, qf, st[kt]);
      }
    }
    bf16x8 pf[4];
    softmax_far<8>(st, 0.0625f * LOG2E, 0.f, m, ls, O, pf);
#pragma unroll
    for (int sp = 0; sp < 4; ++sp) {
#pragma unroll
      for (int dt = 0; dt < 8; ++dt) {
        const uchar* a = Vs + (16 * sp + 4 * h + q4) * 528 + 64 * dt + 32 * blk + 8 * p4;
        s16x4 lo = tr_read(a), hi = tr_read(a + 8 * 528);
        bf16x8 vf = __builtin_shufflevector(lo, hi, 0, 1, 2, 3, 4, 5, 6, 7);
        O[dt] = mfma32(vf, pf[sp], O[dt]);
      }
    }
  }
  ls += __shfl_xor(ls, 32, 64);
  const float inv = 1.f / ls;
  __syncthreads();
#pragma unroll
  for (int dt = 0; dt < 8; ++dt)
#pragma unroll
    for (int g = 0; g < 4; ++g) {
      uint2 o; o.x = pack2(O[dt][4 * g] * inv, O[dt][4 * g + 1] * inv); o.y = pack2(O[dt][4 * g + 2] * inv, O[dt][4 * g + 3] * inv);
      *(uint2*)(smem + (wave * 32 + r31) * 528 + (32 * dt + 8 * g + 4 * h) * 2) = o;
    }
  __syncthreads();
#pragma unroll 4
  for (int i = 0; i < 16; ++i) {
    const int id = tid + 256 * i, row = (id >> 2) & 127, c = ((id >> 9) << 2) | (id & 3);
    const uint4 v = *(const uint4*)(smem + row * 528 + c * 16);
    *(uint4*)(Ob + kblk(NT, (size_t)b * SL + qb * 128 + row, hd * 256 + c * 8)) = v;
  }
}


#ifdef NO_CMP
#define CALL_CMP(x)
#else
#define CALL_CMP(x) x
#endif
#ifdef NO_DSA
#define CALL_DSA(x)
#else
#define CALL_DSA(x) x
#endif
#ifdef NO_DIFF
#define CALL_DIFF(x)
#else
#define CALL_DIFF(x) x
#endif
#ifdef NO_MOBA
#define CALL_MOBA(x)
#else
#define CALL_MOBA(x) x
#endif
#ifdef NO_NSA
#define CALL_NSA(x)
#else
#define CALL_NSA(x) x
#endif
#ifdef NO_CROSS
#define CALL_CROSS(x)
#else
#define CALL_CROSS(x) x
#endif

#define XB_TMO      128
#define XB_XCNT(j)  (256  + 64 * (j))
#define XB_XSUB(j)  (1280 + 64 * (j))
#define XB_XGEN(j)  (2304 + 64 * (j))
#define XB_TOP      3328
#define XB_TOPGEN   3392
#define XB_SPIN_CAP (1u << 22)
#define LAS __attribute__((address_space(3)))
DI unsigned xb_ld(unsigned* p)              { return __hip_atomic_load(p, __ATOMIC_RELAXED, __HIP_MEMORY_SCOPE_AGENT); }
DI unsigned xb_add(unsigned* p, unsigned v) { return __hip_atomic_fetch_add(p, v, __ATOMIC_RELAXED, __HIP_MEMORY_SCOPE_AGENT); }
DI unsigned xb_xcc_id() { return (unsigned)__builtin_amdgcn_s_getreg((3 << 11) | 20) & 0xFu; }
#define XB_SPIN(cond, bar) do { unsigned _sp = 0; while (cond) { __builtin_amdgcn_s_sleep(1); \
    if ((++_sp & 255u) == 0u) { if (xb_ld(&(bar)[XB_TMO])) break; if (_sp > XB_SPIN_CAP) { atomicAdd(&(bar)[XB_TMO], 1u); break; } } } } while (0)
struct XcdBarrier { unsigned* bar; unsigned x; volatile LAS unsigned* st; };
DI XcdBarrier xcd_barrier_post(unsigned* bar, volatile LAS unsigned* st) {
  XcdBarrier b; b.bar = bar; b.x = xb_xcc_id(); b.st = st;
  if (threadIdx.x == 0) (void)xb_add(&bar[XB_XCNT(b.x)], 1u);
  return b;
}
DI void xcd_barrier_complete(unsigned* bar, unsigned x, unsigned& nloc, unsigned& nx) {
  const unsigned G = gridDim.x * gridDim.y * gridDim.z;
  unsigned sum, cnt, mine, sp = 0u;
  for (;;) {
    sum = 0u; cnt = 0u; mine = 0u;
#pragma unroll
    for (unsigned j = 0; j < 16; ++j) { const unsigned c = xb_ld(&bar[XB_XCNT(j)]); sum += c; cnt += (c > 0u) ? 1u : 0u; mine = (j == x) ? c : mine; }
    if (sum == G) break;
    __builtin_amdgcn_s_sleep(1);
    if ((++sp & 255u) == 0u) { if (xb_ld(&bar[XB_TMO])) break; if (sp > XB_SPIN_CAP) { atomicAdd(&bar[XB_TMO], 1u); break; } }
  }
  nloc = mine > 0u ? mine : 1u; nx = cnt > 0u ? cnt : 1u;
}
DI void xcd_barrier(const XcdBarrier& b) {
  asm volatile("s_waitcnt vmcnt(0)" ::: "memory");
  __syncthreads();
  if (threadIdx.x == 0) {
    unsigned* bar = b.bar;
    __builtin_amdgcn_s_waitcnt(0);
    unsigned nloc = b.st[0], nx = b.st[1];
    if (nloc == 0u) { xcd_barrier_complete(bar, b.x, nloc, nx); b.st[0] = nloc; b.st[1] = nx; }
    const unsigned old = xb_add(&bar[XB_XSUB(b.x)], 1u);
    const unsigned gen = old / nloc;
    if (old + 1u == (gen + 1u) * nloc) {
      __builtin_amdgcn_fence(__ATOMIC_RELEASE, "agent");
      asm volatile("s_waitcnt vmcnt(0)" ::: "memory");
      const unsigned og = xb_add(&bar[XB_TOP], 1u);
      const unsigned tg = og / nx;
      if (og + 1u == (tg + 1u) * nx) xb_add(&bar[XB_TOPGEN], 1u);
      else XB_SPIN(xb_ld(&bar[XB_TOPGEN]) == tg, bar);
      __builtin_amdgcn_fence(__ATOMIC_ACQUIRE, "agent");
      xb_add(&bar[XB_XGEN(b.x)], 1u);
      asm volatile("s_waitcnt vmcnt(0)" ::: "memory");
    } else {
      XB_SPIN(xb_ld(&bar[XB_XGEN(b.x)]) == gen, bar);
      __builtin_amdgcn_fence(__ATOMIC_ACQUIRE, "agent");
      asm volatile("s_waitcnt vmcnt(0)" ::: "memory");
    }
  }
  __syncthreads();
}

__global__ void __launch_bounds__(NTHREADS, 2) fwd_megakernel(Params PARG) {
  __shared__ __attribute__((aligned(16))) uchar smem[LDS_BYTES];
  __shared__ int s_slot;
  cg::grid_group grid = cg::this_grid();
  __shared__ uint4 xb_words;
  if (threadIdx.x == 0) xb_words = make_uint4(0u, 0u, 0u, 0u);
  __syncthreads();
  const XcdBarrier xb = xcd_barrier_post((unsigned*)(kparams().ws() + OFF_BAR), (volatile LAS unsigned*)&xb_words);
  {
    const KP P = kparams();
    uchar* ws = P.ws();
    convert_flat(P.in(0), (u16*)(ws + OFF_XB), (size_t)NT * DM);
    convert_flat(P.in(1), (u16*)(ws + OFF_MEMB), (size_t)2048 * 1024);
    convert_layer_weights(PARG, 0, smem);
  }
  grid.sync();
  for (int l = 0; l < DEPTH; ++l) {
    const KP P = kparams();
    uchar* ws = P.ws();
    const uchar* wts = ws + ((l & 1) ? OFF_WALT : 0);
    u16* Xb = (u16*)(ws + OFF_XB);
    u16* Hb = (u16*)(ws + OFF_H);
    u16* Ob = (u16*)(ws + OFF_O);
    unsigned* ctr = (unsigned*)(ws + OFF_CTR);
    float* X = P.out();
    for (int rep = 0; rep < REP_G; ++rep) {
    { LnArgs kq{nullptr, nullptr, nullptr, nullptr, (float2*)(ws + OFF_KIF), 0u};
      gemm_phase<EPI_BF16>(Xb, NT, (const u16*)(wts + W_IN), HC, NT, HC, DM, Hb, HC, nullptr, smem, 0, kq); }
    xcd_barrier(xb);
    }
    for (int rep = 0; rep < REP_P2; ++rep) {
      unsigned* c = ctr + l * 64 + 0 + rep * 32;
      const int n_cmp = 2 * 8 * 51, n_km = 128, n_kv = 128;
      for (;;) {
        int it = next_item(c, &s_slot);
        if (it >= n_cmp + n_km + n_kv) break;
        if (it < n_cmp) { CALL_CMP(compress_item(PARG, l, it, smem)); }
        else if (it < n_cmp + n_km) { kmean_item(PARG, it - n_cmp, smem); }
        else {
          const int t = it - n_cmp - n_km;
          __syncthreads();
          gemm_tile256<EPI_BF16>((const u16*)(ws + OFF_MEMB), 2048, (const u16*)(wts + W_XK), 2048, DM, (t >> 4) * 256, (t & 15) * 128, (u16*)(ws + OFF_KV), 2048, nullptr, smem);
        }
      }
      int att = 0, b = 0;
      for (;;) {
        int it = next_item_b(ctr + l * 64 + 8 + rep * 32, 1024, att, b, &s_slot);
        if (it < 0) break;
        CALL_DSA(dsa_item(PARG, b, it, smem));
      }
    }
    xcd_barrier(xb);
    for (int rep = 0; rep < REP_P3; ++rep) {
      int att = 0, b = 0;
      for (;;) {
        int it = next_item_b(ctr + l * 64 + 16 + rep * 32, 512, att, b, &s_slot);
        if (it < 0) break;
        if (it < 128) { CALL_DIFF(diff_item(PARG, l, b, it, smem)); }
        else if (it < 256) { CALL_DSA(dsa_dense_item(PARG, b, it - 128, smem)); }
        else if (it < 384) { CALL_MOBA(moba_item(PARG, b, it - 256, smem)); }
        else { CALL_NSA(nsa_item(PARG, b, it - 384, smem)); }
      }
    }
    xcd_barrier(xb);
    { LnArgs ln{P.in(16) + l * DM, P.in(17) + l * DM, nullptr, ctr + 256, (float2*)(ws + OFF_STATS), 8u * (unsigned)(l * 3 + 1)};
      gemm_phase<EPI_RESID>(Ob, NT, (const u16*)(wts + W_OUT), DM, NT, DM, DM, nullptr, DM, Xb, smem, 0, ln); }
    xcd_barrier(xb);
    gemm_phase<EPI_QF>(Xb, NT, (const u16*)(wts + W_XQ), DM, NT, DM, DM, Hb, DM, nullptr, smem, 0);
    xcd_barrier(xb);
    for (int rep = 0; rep < REP_X; ++rep) {
      int att = 0, b = 0;
      for (;;) {
        int it = next_item_b(ctr + l * 64 + 24 + rep * 32, 128, att, b, &s_slot);
        if (it < 0) break;
        CALL_CROSS(cross_item(PARG, b, it, smem));
      }
    }
    xcd_barrier(xb);
    { LnArgs ln{P.in(22) + l * DM, P.in(23) + l * DM, nullptr, ctr + 256, (float2*)(ws + OFF_STATS), 8u * (unsigned)(l * 3 + 2)};
      gemm_phase<EPI_RESID>(Ob, NT, (const u16*)(wts + W_XO), DM, NT, DM, DM, nullptr, DM, Xb, smem, 0, ln); }
    xcd_barrier(xb);
    for (int rep = 0; rep < REP_G; ++rep) {
    gemm_phase<EPI_RELU2>(Xb, NT, (const u16*)(wts + W_1), DFF, NT, DFF, DM, Hb, DFF, nullptr, smem, 0);
    xcd_barrier(xb);
    }
    { LnArgs ln{P.in(26) + l * DM, P.in(27) + l * DM, (l == DEPTH - 1) ? P.out() : nullptr, ctr + 256, (float2*)(ws + OFF_STATS), 8u * (unsigned)(l * 3 + 3)};
      gemm_phase<EPI_RESID>(Hb, NT, (const u16*)(wts + W_2), DM, NT, DM, DFF, nullptr, DM, Xb, smem, 0, ln); }
    if (l + 1 < DEPTH) convert_layer_weights(PARG, l + 1, smem);
    xcd_barrier(xb);
  }
}

extern "C" void kernel_launch(void* const* d_in, const int* in_sizes, int n_in, void* d_out, int out_size, void* d_ws, size_t ws_size,
                              hipStream_t stream) {
  static int grid_blocks = 0;
  if (!grid_blocks) {
    int dev = 0, cus = 0, per_cu = 0;
    hipGetDevice(&dev);
    hipDeviceGetAttribute(&cus, hipDeviceAttributeMultiprocessorCount, dev);
    hipOccupancyMaxActiveBlocksPerMultiprocessor(&per_cu, fwd_megakernel, NTHREADS, 0);
    if (per_cu < 1) per_cu = 1;
    if (per_cu > 2) per_cu = 2;
    grid_blocks = cus * per_cu;
    if (ws_size < WS_END) fprintf(stderr, "workspace too small: %zu < %zu\n", ws_size, (size_t)WS_END);
  }
  Params p{};
  for (int i = 0; i < 28; ++i) p.in[i] = (const float*)d_in[i];
  p.out = (float*)d_out;
  p.ws = (uchar*)d_ws;
  hipMemsetAsync((uchar*)d_ws + OFF_CTR, 0, CTR_BYTES + BAR_BYTES, stream);
  void* args[] = {&p};
  hipError_t e = hipLaunchCooperativeKernel((void*)fwd_megakernel, dim3(grid_blocks), dim3(NTHREADS), args, 0, stream);
  if (e != hipSuccess) fprintf(stderr, "cooperative launch failed: %s (grid %d)\n", hipGetErrorString(e), grid_blocks);
}
```
